# Optimizing an MI355X kernel written in HIP

```python
import jax, jax.numpy as jnp
from jax import lax
import numpy as np

D_MODEL = 1024
BATCH = 8
SEQ = 2048
DEPTH = 1

DSW_GROUPS = ((128, 1), (512, 4), (2048, 16))
N_DSW_GROUPS = 3
DSW_HEADS_PER_GROUP = 4
DSW_HEAD_DIM = 64
DSW_BLOCK = 128
DSW_QKV_WIDTH = N_DSW_GROUPS * DSW_HEADS_PER_GROUP * DSW_HEAD_DIM
DSW_OUT_WIDTH = DSW_HEADS_PER_GROUP * DSW_HEAD_DIM
ROPE_THETA = 10000.0

GDN_HEADS = 8
GDN_HEAD_DIM = 128
GDN_WIDTH = GDN_HEADS * GDN_HEAD_DIM
GDN_CONV = 4
GDN_CHUNK = 64

D_FF = 2816
EPS = 1e-6

IN_WIDTHS = (DSW_QKV_WIDTH, DSW_QKV_WIDTH, DSW_QKV_WIDTH,
             3 * GDN_WIDTH,
             GDN_HEADS, GDN_HEADS,
             GDN_WIDTH,
             D_MODEL, D_MODEL)
D_IN = sum(IN_WIDTHS)

kernel_name = "hybrid_dilated_swa_gated_deltanet_macaron"


def rmsnorm(x, g):
    xf = x.astype(jnp.float32)
    y = xf * lax.rsqrt(jnp.mean(xf * xf, axis=-1, keepdims=True) + EPS)
    return (y * g.astype(jnp.float32)).astype(x.dtype)


def swiglu(x, w_gate, w_up, w_down):
    return (jax.nn.silu(x @ w_gate) * (x @ w_up)) @ w_down


def rope(x, pos):
    half = x.shape[-1] // 2
    inv_freq = ROPE_THETA ** (-jnp.arange(half, dtype=jnp.float32) / half)
    ang = pos.astype(jnp.float32)[:, None] * inv_freq[None, :]
    cos = jnp.cos(ang)[None, :, None, :]
    sin = jnp.sin(ang)[None, :, None, :]
    xf = x.astype(jnp.float32)
    x1, x2 = xf[..., :half], xf[..., half:]
    return jnp.concatenate([x1 * cos - x2 * sin, x2 * cos + x1 * sin], axis=-1).astype(x.dtype)


def dilated_window_attention(q, k, v, window, dilation):
    B, S, H, Dh = q.shape
    L = S // dilation
    span = window // dilation
    nb = -(-L // DSW_BLOCK)
    Lp = nb * DSW_BLOCK

    def to_blocks(t):
        t = t.reshape(B, L, dilation, H, Dh).transpose(0, 2, 1, 3, 4)
        t = jnp.pad(t, ((0, 0), (0, 0), (0, Lp - L), (0, 0), (0, 0)))
        return t.reshape(B, dilation, nb, DSW_BLOCK, H, Dh)

    def with_prev(t):
        prev = jnp.pad(t, ((0, 0), (0, 0), (1, 0), (0, 0), (0, 0), (0, 0)))[:, :, :-1]
        return jnp.concatenate([prev, t], axis=3)

    qb = to_blocks(q)
    kw = with_prev(to_blocks(k))
    vw = with_prev(to_blocks(v))
    s = jnp.einsum('brnqhd,brnkhd->brnhqk', qb, kw).astype(jnp.float32) * (Dh ** -0.5)
    qi = jnp.arange(nb)[:, None] * DSW_BLOCK + jnp.arange(DSW_BLOCK)[None, :]
    ki = (jnp.arange(nb)[:, None] - 1) * DSW_BLOCK + jnp.arange(2 * DSW_BLOCK)[None, :]
    dist = qi[:, :, None] - ki[:, None, :]
    valid = (dist >= 0) & (dist <= span) & (ki[:, None, :] >= 0)
    s = jnp.where(valid[None, None, :, None], s, -jnp.inf)
    m = jnp.max(s, axis=-1, keepdims=True)
    p = jnp.exp(s - m)
    l = jnp.sum(p, axis=-1, keepdims=True)
    o = jnp.einsum('brnhqk,brnkhd->brnqhd', (p / l).astype(v.dtype), vw)
    lse = (m + jnp.log(l))[..., 0]
    o = o.reshape(B, dilation, Lp, H, Dh)[:, :, :L].transpose(0, 2, 1, 3, 4).reshape(B, S, H, Dh)
    lse = lse.transpose(0, 1, 2, 4, 3).reshape(B, dilation, Lp, H)[:, :, :L]
    lse = lse.transpose(0, 2, 1, 3).reshape(B, S, H)
    return o, lse


def causal_depthwise_conv(x, w):
    K = w.shape[0]
    S = x.shape[1]
    xp = jnp.pad(x, ((0, 0), (K - 1, 0), (0, 0)))
    y = xp[:, 0:S] * w[0]
    for i in range(1, K):
        y = y + xp[:, i:i + S] * w[i]
    return y


def l2norm(x):
    return x * lax.rsqrt(jnp.sum(x * x, axis=-1, keepdims=True) + EPS)


def gated_delta_rule(q, k, v, beta, g):
    B, S, H, Dk = q.shape
    Dv = v.shape[-1]
    C = GDN_CHUNK
    n = S // C
    q = q * (Dk ** -0.5)
    qc, kc, vc = [t.transpose(0, 2, 1, 3).reshape(B, H, n, C, t.shape[-1]) for t in (q, k, v)]
    bc, gc = [t.transpose(0, 2, 1).reshape(B, H, n, C) for t in (beta, g)]
    gcum = jnp.cumsum(gc, axis=-1)
    tri = jnp.tril(jnp.ones((C, C), dtype=bool))
    tri_strict = jnp.tril(jnp.ones((C, C), dtype=bool), -1)
    decay = jnp.exp(jnp.where(tri, gcum[..., :, None] - gcum[..., None, :], -jnp.inf))
    kbeta = kc * bc[..., None]
    vbeta = vc * bc[..., None]
    M = jnp.where(tri_strict, jnp.einsum('bhnid,bhnjd->bhnij', kbeta, kc) * decay, 0.0)
    A = M + jnp.eye(C, dtype=M.dtype)
    rhs = jnp.concatenate([vbeta, kbeta * jnp.exp(gcum)[..., None]], axis=-1)
    sol = lax.linalg.triangular_solve(A, rhs, left_side=True, lower=True, unit_diagonal=True)
    u, w = sol[..., :Dv], sol[..., Dv:]
    a_qk = jnp.einsum('bhnid,bhnjd->bhnij', qc, kc) * decay
    q_dec = qc * jnp.exp(gcum)[..., None]
    g_last = gcum[..., -1]
    k_dec = kc * jnp.exp(g_last[..., None] - gcum)[..., None]
    state_dec = jnp.exp(g_last)

    def step(state, inp):
        q_i, k_i, u_i, w_i, a_i, sd_i = inp
        v_new = u_i - jnp.einsum('bhck,bhkv->bhcv', w_i, state)
        o_i = jnp.einsum('bhck,bhkv->bhcv', q_i, state) + jnp.einsum('bhij,bhjv->bhiv', a_i, v_new)
        state = state * sd_i[..., None, None] + jnp.einsum('bhck,bhcv->bhkv', k_i, v_new)
        return state, o_i

    xs = tuple(jnp.moveaxis(t, 2, 0) for t in (q_dec, k_dec, u, w, a_qk, state_dec))
    state0 = jnp.zeros((B, H, Dk, Dv), dtype=jnp.float32)
    _, o = lax.scan(step, state0, xs)
    return jnp.moveaxis(o, 0, 2).reshape(B, H, S, Dv).transpose(0, 2, 1, 3)


def hybrid_mixer(h, pos, w_in, gdn_conv_w, gdn_a_log, gdn_dt_bias, gdn_out_norm,
                 w_branch_a, w_branch_b, w_out):
    B, S, _ = h.shape
    offsets = []
    acc = 0
    for wdt in IN_WIDTHS[:-1]:
        acc += wdt
        offsets.append(acc)
    qa, ka, va, qkv_b, beta_raw, decay_raw, gdn_gate, gate_a, gate_b = jnp.split(h @ w_in, offsets, axis=-1)

    n_a = N_DSW_GROUPS * DSW_HEADS_PER_GROUP
    qa = rope(qa.reshape(B, S, n_a, DSW_HEAD_DIM), pos)
    ka = rope(ka.reshape(B, S, n_a, DSW_HEAD_DIM), pos)
    va = va.reshape(B, S, n_a, DSW_HEAD_DIM)
    outs, lses = [], []
    for gi, (window, dilation) in enumerate(DSW_GROUPS):
        sl = slice(gi * DSW_HEADS_PER_GROUP, (gi + 1) * DSW_HEADS_PER_GROUP)
        o, lse = dilated_window_attention(qa[:, :, sl], ka[:, :, sl], va[:, :, sl], window, dilation)
        outs.append(o)
        lses.append(lse)
    wts = jax.nn.softmax(jnp.stack(lses, axis=0), axis=0)
    ya = jnp.einsum('gbsh,gbshd->bshd', wts.astype(h.dtype), jnp.stack(outs, axis=0))
    ya = ya.reshape(B, S, DSW_OUT_WIDTH)

    qkv = jax.nn.silu(causal_depthwise_conv(qkv_b, gdn_conv_w)).astype(jnp.float32)
    qb, kb, vb = jnp.split(qkv, 3, axis=-1)
    qb = l2norm(qb.reshape(B, S, GDN_HEADS, GDN_HEAD_DIM))
    kb = l2norm(kb.reshape(B, S, GDN_HEADS, GDN_HEAD_DIM))
    vb = vb.reshape(B, S, GDN_HEADS, GDN_HEAD_DIM)
    beta = jax.nn.sigmoid(beta_raw.astype(jnp.float32))
    g = -jnp.exp(gdn_a_log.astype(jnp.float32)) * jax.nn.softplus(
        decay_raw.astype(jnp.float32) + gdn_dt_bias.astype(jnp.float32))
    ob = gated_delta_rule(qb, kb, vb, beta, g)
    ob = rmsnorm(ob, gdn_out_norm) * jax.nn.silu(
        gdn_gate.astype(jnp.float32).reshape(B, S, GDN_HEADS, GDN_HEAD_DIM))
    yb = ob.reshape(B, S, GDN_WIDTH).astype(h.dtype)

    merged = jax.nn.sigmoid(gate_a) * (ya @ w_branch_a) + jax.nn.sigmoid(gate_b) * (yb @ w_branch_b)
    return merged @ w_out


def setup_inputs(seed: int = 0) -> dict:
    key = jax.random.key(seed)
    ks = jax.random.split(key, 20)
    f32 = jnp.float32

    def nrm(k, shape, fan_in):
        return jax.random.normal(k, shape, f32) * (fan_in ** -0.5)

    def gain(k, shape):
        return 1.0 + 0.01 * jax.random.normal(k, shape, f32)

    dt = jnp.exp(jax.random.uniform(ks[9], (DEPTH, GDN_HEADS), f32, np.log(1e-3), np.log(1e-1)))
    return {
        "x": jax.random.normal(ks[0], (BATCH, SEQ, D_MODEL), f32),
        "ffn1_norm": gain(ks[1], (DEPTH, D_MODEL)),
        "ffn1_w_gate": nrm(ks[2], (DEPTH, D_MODEL, D_FF), D_MODEL),
        "ffn1_w_up": nrm(ks[3], (DEPTH, D_MODEL, D_FF), D_MODEL),
        "ffn1_w_down": nrm(ks[4], (DEPTH, D_FF, D_MODEL), D_FF),
        "mix_norm": gain(ks[5], (DEPTH, D_MODEL)),
        "w_in": nrm(ks[6], (DEPTH, D_MODEL, D_IN), D_MODEL),
        "gdn_conv_w": nrm(ks[7], (DEPTH, GDN_CONV, 3 * GDN_WIDTH), GDN_CONV),
        "gdn_a_log": jnp.log(jax.random.uniform(ks[8], (DEPTH, GDN_HEADS), f32, 1.0, 16.0)),
        "gdn_dt_bias": dt + jnp.log(-jnp.expm1(-dt)),
        "gdn_out_norm": gain(ks[10], (DEPTH, GDN_HEAD_DIM)),
        "w_branch_a": nrm(ks[11], (DEPTH, DSW_OUT_WIDTH, D_MODEL), DSW_OUT_WIDTH),
        "w_branch_b": nrm(ks[12], (DEPTH, GDN_WIDTH, D_MODEL), GDN_WIDTH),
        "w_out": nrm(ks[13], (DEPTH, D_MODEL, D_MODEL), D_MODEL),
        "ffn2_norm": gain(ks[14], (DEPTH, D_MODEL)),
        "ffn2_w_gate": nrm(ks[15], (DEPTH, D_MODEL, D_FF), D_MODEL),
        "ffn2_w_up": nrm(ks[16], (DEPTH, D_MODEL, D_FF), D_MODEL),
        "ffn2_w_down": nrm(ks[17], (DEPTH, D_FF, D_MODEL), D_FF),
        "final_norm": gain(ks[18], (D_MODEL,)),
    }


def reference(x, ffn1_norm, ffn1_w_gate, ffn1_w_up, ffn1_w_down, mix_norm, w_in, gdn_conv_w,
              gdn_a_log, gdn_dt_bias, gdn_out_norm, w_branch_a, w_branch_b, w_out,
              ffn2_norm, ffn2_w_gate, ffn2_w_up, ffn2_w_down, final_norm):
    pos = jnp.arange(x.shape[1])
    for layer in range(DEPTH):
        x = x + 0.5 * swiglu(rmsnorm(x, ffn1_norm[layer]),
                             ffn1_w_gate[layer], ffn1_w_up[layer], ffn1_w_down[layer])
        h = rmsnorm(x, mix_norm[layer])
        x = x + hybrid_mixer(h, pos, w_in[layer], gdn_conv_w[layer], gdn_a_log[layer],
                             gdn_dt_bias[layer], gdn_out_norm[layer], w_branch_a[layer],
                             w_branch_b[layer], w_out[layer])
        x = x + 0.5 * swiglu(rmsnorm(x, ffn2_norm[layer]),
                             ffn2_w_gate[layer], ffn2_w_up[layer], ffn2_w_down[layer])
    return rmsnorm(x, final_norm)
```

```cpp
#include <hip/hip_runtime.h>
#include <hip/hip_cooperative_groups.h>
#include <cstdio>
#include <cstdint>
namespace cg = cooperative_groups;
#ifndef MK_PROBE
#define MK_PROBE 0
#endif
namespace pg8 {
#define PG8_LAS __attribute__((address_space(3)))
typedef unsigned short bf16_t;
typedef short bf16x8 __attribute__((ext_vector_type(8)));
typedef float f32x4 __attribute__((ext_vector_type(4)));
typedef unsigned u32x4 __attribute__((ext_vector_type(4)));
constexpr int BM = 256, BK = 64, HALF = 128, HTB = HALF * BK * 2  , STAGE_BYTES = 8 * HTB, NXCD = 8, WGM = 8;

__host__ __device__ __forceinline__ int lds_byte(int r, int c) { const int st = (r >> 4) * 2 + (c >> 5), rr = r & 15, cc = c & 31, ob = rr * 64 + cc * 2; return st * 1024 + (ob ^ (((ob >> 9) & 1) << 5)); }
__host__ __device__ __forceinline__ void stage_rc(int b, int& R, int& C) { const int st = b / 1024, sb = b % 1024, swz = sb ^ (((sb >> 9) & 1) << 5); R = (st >> 1) * 16 + swz / 64; C = (st & 1) * 32 + (swz % 64) / 2; }
__host__ __device__ __forceinline__ int perm32(int rho) { const int n = rho >> 4, i = rho & 15; return 8 * (i >> 2) + 4 * n + (i & 3); }

struct Unit { int pm, pn; };
struct Gemm { const bf16_t* A; const bf16_t* Bt; int M, N, K; };

struct StaticOrder {
    int nM, nN, nwg, G, c;
    __host__ __device__ void init(int M, int N, int G_, int c_) { nM = M / BM; nN = N / BM; nwg = nM * nN; G = G_; c = c_; }
    __host__ __device__ bool next(int i, Unit& u) const {
        const long L = (long)i * G + c; if (L >= nwg) return false;
        int wgid = (int)L; { const int q = nwg / NXCD, r = nwg % NXCD, xcd = wgid % NXCD, off = wgid / NXCD; wgid = (xcd < r ? xcd * (q + 1) : r * (q + 1) + (xcd - r) * q) + off; }
        const int nig = WGM * nN, gid = wgid / nig, fm = gid * WGM, gsz = (nM - fm) < WGM ? (nM - fm) : WGM;
        u.pm = fm + ((wgid % nig) % gsz); u.pn = (wgid % nig) / gsz; return true;
    }
    __device__ __forceinline__ void a_ready(const Unit&) const {}
    __device__ __forceinline__ void done(const Unit&) const {}
};

__device__ __forceinline__ unsigned cvt_pk_bf16(float lo, float hi) { unsigned r; asm volatile("v_cvt_pk_bf16_f32 %0, %1, %2" : "=v"(r) : "v"(lo), "v"(hi)); return r; }
typedef float f32x2_t __attribute__((ext_vector_type(2))); typedef __bf16 bf16x2_t __attribute__((ext_vector_type(2)));
typedef unsigned u32x2 __attribute__((ext_vector_type(2)));
__device__ __forceinline__ unsigned pk2(float lo, float hi) { f32x2_t v = {lo, hi}; bf16x2_t b = __builtin_convertvector(v, bf16x2_t); return __builtin_bit_cast(unsigned, b); }
__device__ __forceinline__ float bflo(unsigned w) { return __builtin_bit_cast(float, w << 16); }
__device__ __forceinline__ float bfhi(unsigned w) { return __builtin_bit_cast(float, w & 0xffff0000u); }
__device__ __forceinline__ float sigm(float x) { return __builtin_amdgcn_rcpf(1.f + __expf(-x)); }
__device__ __forceinline__ float siluf(float x) { return x * sigm(x); }
__device__ __forceinline__ float row_rs(const float* ssq, int row) {
    const f32x4* p = (const f32x4*)(ssq + (size_t)row * 16);
    const f32x4 a = p[0], b = p[1], c = p[2], d = p[3];
    const float s = ((a[0] + a[1]) + (a[2] + a[3])) + ((b[0] + b[1]) + (b[2] + b[3])) + ((c[0] + c[1]) + (c[2] + c[3])) + ((d[0] + d[1]) + (d[2] + d[3]));
    return rsqrtf(s * (1.f / 1024.f) + 1e-6f);
}
__device__ __forceinline__ void row_rs8(const float* ssq, int row0, int fq, float (&rs)[2][4]) {
    f32x4 p[2][4];
#pragma unroll
    for (int ai = 0; ai < 2; ++ai)
#pragma unroll
        for (int m = 0; m < 4; ++m) p[ai][m] = *((const f32x4*)(ssq + (size_t)(row0 + ai * HALF + m * 16) * 16) + fq);
#pragma unroll
    for (int ai = 0; ai < 2; ++ai)
#pragma unroll
        for (int m = 0; m < 4; ++m) { float t = (p[ai][m][0] + p[ai][m][1]) + (p[ai][m][2] + p[ai][m][3]); t += __shfl_xor(t, 16); t += __shfl_xor(t, 32); rs[ai][m] = rsqrtf(t * (1.f / 1024.f) + 1e-6f); }
}
struct EpiSwiglu {
    static constexpr bool PERM = true, AFTER_DRAIN = false;
    bf16_t* O; const float* ssq;
    __device__ __forceinline__ void operator()(const f32x4 (&acc)[2][2][4][2], const Unit& u, int wr, int wc, int fr, int fq) const {
        const int row0 = u.pm * BM + wr * 64 + fr, col0 = u.pn * 128 + wc * 32 + 8 * fq; float rsv[2][4]; row_rs8(ssq, row0, fq, rsv);
#pragma unroll
        for (int ai = 0; ai < 2; ++ai)
#pragma unroll
            for (int m = 0; m < 4; ++m) {
                const int row = row0 + ai * HALF + m * 16; const float rs = rsv[ai][m];
                float h[8];
#pragma unroll
                for (int n = 0; n < 2; ++n)
#pragma unroll
                    for (int x = 0; x < 4; ++x) { const float g = acc[ai][0][m][n][x] * rs, up = acc[ai][1][m][n][x] * rs; h[4 * n + x] = siluf(g) * up; }
                u32x4 w; w.x = pk2(h[0], h[1]); w.y = pk2(h[2], h[3]); w.z = pk2(h[4], h[5]); w.w = pk2(h[6], h[7]);
                *(u32x4*)(O + (size_t)row * 2816 + col0) = w;
            }
    }
};
struct EpiResid {
    static constexpr bool PERM = false, AFTER_DRAIN = false;
    const float* res; float* out; bf16_t* xn; const float* gain; float* ssq; float scale;
    __device__ __forceinline__ void operator()(const f32x4 (&acc)[2][2][4][2], const Unit& u, int wr, int wc, int fr, int fq) const {
        const int row0 = u.pm * BM + wr * 64 + fr, colb = u.pn * BM + wc * 32 + 4 * fq;
        f32x4 g[2][2];
        if (xn) {
#pragma unroll
            for (int bj = 0; bj < 2; ++bj)
#pragma unroll
                for (int n = 0; n < 2; ++n) g[bj][n] = *(const f32x4*)(gain + colb + bj * HALF + n * 16); }
#pragma unroll
        for (int ai = 0; ai < 2; ++ai) {
            f32x4 r[2][2][2];
#pragma unroll
          for (int mh = 0; mh < 2; ++mh) {
#pragma unroll
            for (int m2 = 0; m2 < 2; ++m2)
#pragma unroll
                for (int bj = 0; bj < 2; ++bj)
#pragma unroll
                    for (int n = 0; n < 2; ++n) r[m2][bj][n] = *(const f32x4*)(res + (size_t)(row0 + ai * HALF + (2 * mh + m2) * 16) * 1024 + colb + bj * HALF + n * 16);
#pragma unroll
            for (int m2 = 0; m2 < 2; ++m2) { const int m = 2 * mh + m2;
                const int row = row0 + ai * HALF + m * 16; float ss = 0.f;
#pragma unroll
                for (int bj = 0; bj < 2; ++bj)
#pragma unroll
                    for (int n = 0; n < 2; ++n) {
                        const size_t off = (size_t)row * 1024 + colb + bj * HALF + n * 16;
                        const f32x4 o = r[m2][bj][n] + acc[ai][bj][m][n] * scale;
                        *(f32x4*)(out + off) = o; ss += (o[0] * o[0] + o[1] * o[1]) + (o[2] * o[2] + o[3] * o[3]);
                        if (xn) { const f32x4 gg = g[bj][n]; u32x2 w; w.x = pk2(o[0] * gg[0], o[1] * gg[1]); w.y = pk2(o[2] * gg[2], o[3] * gg[3]); *(u32x2*)(xn + off) = w; }
                    }
                ss += __shfl_xor(ss, 16); ss += __shfl_xor(ss, 32);
                if (fq == 0) ssq[(size_t)row * 16 + u.pn * 4 + wc] = ss;
            }
          }
        }
    }
};
struct EpiFinal {
    static constexpr bool PERM = false, AFTER_DRAIN = false;
    const float* res; float* out; const float* gain; float* xb; unsigned* cnt; float scale;
    __device__ __forceinline__ void operator()(const f32x4 (&acc)[2][2][4][2], const Unit& u, int wr, int wc, int fr, int fq) const {
        const int row0 = u.pm * BM + wr * 64 + fr, colb = u.pn * BM + wc * 32 + 4 * fq, lane = threadIdx.x & 63;
#pragma unroll
        for (int ai = 0; ai < 2; ++ai) {
            f32x4 r[2][2][2];
#pragma unroll
          for (int mh = 0; mh < 2; ++mh) {
#pragma unroll
            for (int m2 = 0; m2 < 2; ++m2)
#pragma unroll
                for (int bj = 0; bj < 2; ++bj)
#pragma unroll
                    for (int n = 0; n < 2; ++n) r[m2][bj][n] = *(const f32x4*)(res + (size_t)(row0 + ai * HALF + (2 * mh + m2) * 16) * 1024 + colb + bj * HALF + n * 16);
#pragma unroll
            for (int m2 = 0; m2 < 2; ++m2) { const int m = 2 * mh + m2;
                const int row = row0 + ai * HALF + m * 16; float ss = 0.f;
#pragma unroll
                for (int bj = 0; bj < 2; ++bj)
#pragma unroll
                    for (int n = 0; n < 2; ++n) { const f32x4 o = r[m2][bj][n] + acc[ai][bj][m][n] * scale; ss += (o[0] * o[0] + o[1] * o[1]) + (o[2] * o[2] + o[3] * o[3]); }
                ss += __shfl_xor(ss, 16); ss += __shfl_xor(ss, 32);
                if (fq == 0) __hip_atomic_store(xb + (size_t)row * 16 + u.pn * 4 + wc, ss, __ATOMIC_RELAXED, __HIP_MEMORY_SCOPE_AGENT);
            }
          }
        }
        asm volatile("s_waitcnt vmcnt(0)" ::: "memory");
        unsigned* c = cnt + 64 * u.pm;
        if (lane == 0) __hip_atomic_fetch_add(c, 1u, __ATOMIC_RELAXED, __HIP_MEMORY_SCOPE_AGENT);
        { unsigned sp = 0;
          while ((unsigned)__builtin_amdgcn_readfirstlane(__hip_atomic_load(c, __ATOMIC_RELAXED, __HIP_MEMORY_SCOPE_AGENT)) < 32u) { __builtin_amdgcn_s_sleep(2); if (++sp > (1u << 22)) break; } }
        __builtin_amdgcn_fence(__ATOMIC_ACQUIRE, "agent"); asm volatile("s_waitcnt vmcnt(0)" ::: "memory");
        float rsv[2][4]; row_rs8(xb, row0, fq, rsv);
        f32x4 g[2][2];
#pragma unroll
        for (int bj = 0; bj < 2; ++bj)
#pragma unroll
            for (int n = 0; n < 2; ++n) g[bj][n] = *(const f32x4*)(gain + colb + bj * HALF + n * 16);
#pragma unroll
        for (int ai = 0; ai < 2; ++ai) {
            f32x4 r[2][2][2];
#pragma unroll
          for (int mh = 0; mh < 2; ++mh) {
#pragma unroll
            for (int m2 = 0; m2 < 2; ++m2)
#pragma unroll
                for (int bj = 0; bj < 2; ++bj)
#pragma unroll
                    for (int n = 0; n < 2; ++n) r[m2][bj][n] = *(const f32x4*)(res + (size_t)(row0 + ai * HALF + (2 * mh + m2) * 16) * 1024 + colb + bj * HALF + n * 16);
#pragma unroll
            for (int m2 = 0; m2 < 2; ++m2) { const int m = 2 * mh + m2;
                const int row = row0 + ai * HALF + m * 16; const float rs = rsv[ai][m];
#pragma unroll
                for (int bj = 0; bj < 2; ++bj)
#pragma unroll
                    for (int n = 0; n < 2; ++n) { const f32x4 o = r[m2][bj][n] + acc[ai][bj][m][n] * scale; const f32x4 gg = g[bj][n];
                        *(f32x4*)(out + (size_t)row * 1024 + colb + bj * HALF + n * 16) = (f32x4){o[0] * rs * gg[0], o[1] * rs * gg[1], o[2] * rs * gg[2], o[3] * rs * gg[3]}; }
            }
          }
        }
    }
};
struct EpiIn {
    static constexpr bool PERM = true, AFTER_DRAIN = false;
    unsigned char* ws; size_t offQA, offVA, offQB; float* BD; const float* ssq; const float* ropec; const float* ropes; const float* a_log; const float* dt_bias; int pn_off;
    __device__ __forceinline__ void operator()(const f32x4 (&acc)[2][2][4][2], const Unit& u, int wr, int wc, int fr, int fq) const {
        float rsv[2][4]; row_rs8(ssq, u.pm * BM + wr * 64 + fr, fq, rsv);
        const int row0 = u.pm * BM + wr * 64 + fr, lt = u.pn + pn_off;
        const int pn = lt < 3 ? lt : (lt < 15 ? lt + 6 : (lt == 15 ? 21 : lt - 13));
        if (pn < 6) {
            bf16_t* dst = (bf16_t*)(ws + offQA + (size_t)(pn / 3) * (24u << 20)); const int cb = (pn % 3) * 256 + wc * 64 + 8 * fq; const float sc = pn < 3 ? 0.125f : 1.f;
#pragma unroll
            for (int ai = 0; ai < 2; ++ai)
#pragma unroll
              for (int mh = 0; mh < 2; ++mh) {
                f32x4 cs_[2][4];
#pragma unroll
                for (int m2 = 0; m2 < 2; ++m2) { const int pos = (row0 + ai * HALF + (2 * mh + m2) * 16) & 2047;
                    cs_[m2][0] = *(const f32x4*)(ropec + pos * 32 + 8 * fq); cs_[m2][1] = *(const f32x4*)(ropec + pos * 32 + 8 * fq + 4);
                    cs_[m2][2] = *(const f32x4*)(ropes + pos * 32 + 8 * fq); cs_[m2][3] = *(const f32x4*)(ropes + pos * 32 + 8 * fq + 4); }
#pragma unroll
                for (int m2 = 0; m2 < 2; ++m2) { const int m = 2 * mh + m2;
                    const int row = row0 + ai * HALF + m * 16; const float rs = rsv[ai][m] * sc;
                    const f32x4 c0 = cs_[m2][0], c1 = cs_[m2][1], s0 = cs_[m2][2], s1 = cs_[m2][3];
                    float o1[8], o2[8];
#pragma unroll
                    for (int n = 0; n < 2; ++n)
#pragma unroll
                        for (int x = 0; x < 4; ++x) { const float x1 = acc[ai][0][m][n][x] * rs, x2 = acc[ai][1][m][n][x] * rs, c = n ? c1[x] : c0[x], s = n ? s1[x] : s0[x];
                            o1[4 * n + x] = x1 * c - x2 * s; o2[4 * n + x] = x2 * c + x1 * s; }
                    u32x4 w1, w2; w1.x = pk2(o1[0], o1[1]); w1.y = pk2(o1[2], o1[3]); w1.z = pk2(o1[4], o1[5]); w1.w = pk2(o1[6], o1[7]);
                    w2.x = pk2(o2[0], o2[1]); w2.y = pk2(o2[2], o2[3]); w2.z = pk2(o2[4], o2[5]); w2.w = pk2(o2[6], o2[7]);
                    *(u32x4*)(dst + (size_t)row * 768 + cb) = w1; *(u32x4*)(dst + (size_t)row * 768 + cb + 32) = w2;
                }
              }
        } else if (pn < 21) {
            const bool isv = pn < 9; const int pb = pn - 9;
            bf16_t* dst = (bf16_t*)(ws + (isv ? offVA : offQB + (size_t)(pb >> 2) * (32u << 20))); const int ld = isv ? 768 : 1024; int cb = isv ? (pn - 6) * 256 : (pb & 3) * 256;
            cb += wc * 32 + 8 * fq;
#pragma unroll
            for (int ai = 0; ai < 2; ++ai)
#pragma unroll
                for (int m = 0; m < 4; ++m) {
                    const int row = row0 + ai * HALF + m * 16; const float rs = rsv[ai][m];
#pragma unroll
                    for (int bj = 0; bj < 2; ++bj) { const f32x4 v0 = acc[ai][bj][m][0] * rs, v1 = acc[ai][bj][m][1] * rs;
                        u32x4 w; w.x = pk2(v0[0], v0[1]); w.y = pk2(v0[2], v0[3]); w.z = pk2(v1[0], v1[1]); w.w = pk2(v1[2], v1[3]);
                        *(u32x4*)(dst + (size_t)row * ld + cb + bj * HALF) = w; }
                }
        } else {
            if (wc == 0 && fq < 2) {
#pragma unroll
                for (int ai = 0; ai < 2; ++ai)
#pragma unroll
                    for (int m = 0; m < 4; ++m) {
                        const int row = row0 + ai * HALF + m * 16; const float rs = rsv[ai][m];
#pragma unroll
                        for (int n = 0; n < 2; ++n) { f32x4 o;
#pragma unroll
                            for (int x = 0; x < 4; ++x) { const float v = acc[ai][0][m][n][x] * rs; const int hh = 4 * n + x;
                                if (fq == 0) o[x] = 1.f / (1.f + expf(-v));
                                else { const float z = v + dt_bias[hh]; const float sp = fmaxf(z, 0.f) + log1pf(expf(-fabsf(z))); o[x] = -expf(a_log[hh]) * sp; } }
                            *(f32x4*)(BD + (size_t)row * 16 + 8 * fq + 4 * n) = o; }
                    }
            }
        }
    }
};
struct EpiGates {
    static constexpr bool PERM = true, AFTER_DRAIN = false;
    unsigned char* ws; size_t offYB, offG; const float* ssq; int pn_off;
    __device__ __forceinline__ void operator()(const f32x4 (&acc)[2][2][4][2], const Unit& u, int wr, int wc, int fr, int fq) const {
        const int pnn = u.pn + pn_off; const int row0 = u.pm * BM + wr * 64 + fr, kind = pnn >> 2, cb = (pnn & 3) * 256 + wc * 32 + 8 * fq;
        bf16_t* dst = (bf16_t*)(ws + (kind == 0 ? offYB : offG + (size_t)(kind - 1) * (32u << 20)));
        float rsv[2][4]; row_rs8(ssq, row0, fq, rsv);
#pragma unroll
        for (int ai = 0; ai < 2; ++ai) {
            u32x4 yv[4][2];
            if (kind == 0) {
#pragma unroll
                for (int m = 0; m < 4; ++m)
#pragma unroll
                    for (int bj = 0; bj < 2; ++bj) yv[m][bj] = *(const u32x4*)(dst + (size_t)(row0 + ai * HALF + m * 16) * 1024 + cb + bj * HALF); }
#pragma unroll
            for (int m = 0; m < 4; ++m) {
                const int row = row0 + ai * HALF + m * 16; const float rs = rsv[ai][m];
#pragma unroll
                for (int bj = 0; bj < 2; ++bj) { const f32x4 v0 = acc[ai][bj][m][0] * rs, v1 = acc[ai][bj][m][1] * rs;
                    u32x4* p = (u32x4*)(dst + (size_t)row * 1024 + cb + bj * HALF); u32x4 w;
                    if (kind == 0) { const u32x4 y = yv[m][bj];
                        w.x = pk2(bflo(y.x) * siluf(v0[0]), bfhi(y.x) * siluf(v0[1])); w.y = pk2(bflo(y.y) * siluf(v0[2]), bfhi(y.y) * siluf(v0[3]));
                        w.z = pk2(bflo(y.z) * siluf(v1[0]), bfhi(y.z) * siluf(v1[1])); w.w = pk2(bflo(y.w) * siluf(v1[2]), bfhi(y.w) * siluf(v1[3]));
                    } else { w.x = pk2(sigm(v0[0]), sigm(v0[1])); w.y = pk2(sigm(v0[2]), sigm(v0[3])); w.z = pk2(sigm(v1[0]), sigm(v1[1])); w.w = pk2(sigm(v1[2]), sigm(v1[3])); }
                    *p = w; }
            }
        }
    }
};
struct EpiBranch {
    static constexpr bool PERM = true, AFTER_DRAIN = false;
    const bf16_t* gate; const bf16_t* add; bf16_t* out;
    __device__ __forceinline__ void operator()(const f32x4 (&acc)[2][2][4][2], const Unit& u, int wr, int wc, int fr, int fq) const {
        const int row0 = u.pm * BM + wr * 64 + fr, cb = u.pn * 256 + wc * 32 + 8 * fq;
#pragma unroll
        for (int ai = 0; ai < 2; ++ai)
#pragma unroll
            for (int mh = 0; mh < 2; ++mh) {
                u32x4 gv[2][2], av[2][2];
#pragma unroll
                for (int m2 = 0; m2 < 2; ++m2)
#pragma unroll
                    for (int bj = 0; bj < 2; ++bj) { const size_t off = (size_t)(row0 + ai * HALF + (2 * mh + m2) * 16) * 1024 + cb + bj * HALF;
                        gv[m2][bj] = *(const u32x4*)(gate + off); av[m2][bj] = add ? *(const u32x4*)(add + off) : (u32x4){0u, 0u, 0u, 0u}; }
#pragma unroll
                for (int m2 = 0; m2 < 2; ++m2) { const int m = 2 * mh + m2;
#pragma unroll
                    for (int bj = 0; bj < 2; ++bj) { const f32x4 v0 = acc[ai][bj][m][0], v1 = acc[ai][bj][m][1]; const u32x4 g = gv[m2][bj], a = av[m2][bj];
                        const size_t off = (size_t)(row0 + ai * HALF + m * 16) * 1024 + cb + bj * HALF;
                        u32x4 w; w.x = pk2(bflo(a.x) + bflo(g.x) * v0[0], bfhi(a.x) + bfhi(g.x) * v0[1]); w.y = pk2(bflo(a.y) + bflo(g.y) * v0[2], bfhi(a.y) + bfhi(g.y) * v0[3]);
                        w.z = pk2(bflo(a.z) + bflo(g.z) * v1[0], bfhi(a.z) + bfhi(g.z) * v1[1]); w.w = pk2(bflo(a.w) + bflo(g.w) * v1[2], bfhi(a.w) + bfhi(g.w) * v1[3]);
                        *(u32x4*)(out + off) = w; } }
            }
    }
};

template <class Epi, class Sched, bool ALIGN_EPI = false, bool SP2 = false>
__device__ __forceinline__ void gemm_phase(PG8_LAS unsigned char* lds, const Gemm g, const Sched& S, const Epi& E) {
    const int tid = threadIdx.x, wid = __builtin_amdgcn_readfirstlane(tid >> 6), lane = tid & 63, wr = wid >> 2, wc = wid & 3, fr = lane & 15, fq = lane >> 4;
    const int K = g.K, nt = K / BK;
    unsigned voffA[2], voffB[2];
#pragma unroll
    for (int i = 0; i < 2; ++i) { int R, C; stage_rc(tid * 16 + i * 8192, R, C); const int Rb = Epi::PERM ? ((R & ~31) + perm32(R & 31)) : R;
        voffA[i] = (unsigned)(R * K + C) * 2u; voffB[i] = (unsigned)(Rb * K + C) * 2u; }
    const size_t kstep = (size_t)(BK * 2);
    const size_t hstep = (size_t)HALF * K * 2;
    const size_t tstep = 2 * hstep;
    const unsigned ldsw = (unsigned)wid * 1024u;
    const int aoff = lds_byte(wr * 64 + fr, fq * 8), boff = lds_byte(wc * 32 + fr, fq * 8);
#define PG8_SA(b, h) (((b) * 2 + (h)) * HTB)
#define PG8_SB(b, h) ((4 + (b) * 2 + (h)) * HTB)
#define PG8_STAGE(bufoff, gbase, voff) do { _Pragma("unroll") for (int _i = 0; _i < 2; ++_i) \
        __builtin_amdgcn_global_load_lds((const unsigned*)((const char*)(gbase) + (voff)[_i]), (PG8_LAS unsigned*)(lds + (bufoff) + ldsw + _i * 8192), 16, 0, 0); } while (0)
#define PG8_LDA(dst, b, h) do { _Pragma("unroll") for (int m = 0; m < 4; ++m) _Pragma("unroll") for (int k = 0; k < 2; ++k) dst[m][k] = *(const PG8_LAS bf16x8*)(lds + PG8_SA(b, h) + aoff + m * 2048 + k * 1024); } while (0)
#define PG8_LDB(dst, b, h) do { _Pragma("unroll") for (int n = 0; n < 2; ++n) _Pragma("unroll") for (int k = 0; k < 2; ++k) dst[n][k] = *(const PG8_LAS bf16x8*)(lds + PG8_SB(b, h) + boff + n * 2048 + k * 1024); } while (0)
#define PG8_MMA(ai, bj, At, Bt) do { __builtin_amdgcn_s_setprio(1); _Pragma("unroll") for (int m = 0; m < 4; ++m) _Pragma("unroll") for (int n = 0; n < 2; ++n) _Pragma("unroll") for (int k = 0; k < 2; ++k) \
        acc[ai][bj][m][n] = __builtin_amdgcn_mfma_f32_16x16x32_bf16(Bt[n][k], At[m][k], acc[ai][bj][m][n], 0, 0, 0); __builtin_amdgcn_s_setprio(0); } while (0)
#define PG8_WAIT_V(n) asm volatile("s_waitcnt vmcnt(" #n ")" ::: "memory")
#define PG8_WAIT_L(n) asm volatile("s_waitcnt lgkmcnt(" #n ")" ::: "memory")
#define PG8_BAR __builtin_amdgcn_s_barrier()
#define PG8_SCHED __builtin_amdgcn_sched_barrier(0)
    Unit cur, nxt; int ui = 0;
    if (!S.next(0, cur)) return;
    f32x4 acc[2][2][4][2];
#pragma unroll
    for (int a = 0; a < 2; ++a)
#pragma unroll
        for (int b = 0; b < 2; ++b)
#pragma unroll
            for (int m = 0; m < 4; ++m)
#pragma unroll
                for (int n = 0; n < 2; ++n) acc[a][b][m][n] = (f32x4){0.f, 0.f, 0.f, 0.f};
    bf16x8 At[4][2], B0[2][2], B1[2][2];
    const char* cA = (const char*)g.A + (size_t)cur.pm * tstep; const char* cB = (const char*)g.Bt + (size_t)cur.pn * tstep;
    S.a_ready(cur);
    if constexpr (SP2) {
        PG8_STAGE(PG8_SB(0, 0), cB, voffB); PG8_STAGE(PG8_SB(0, 1), cB + hstep, voffB); PG8_STAGE(PG8_SA(0, 0), cA, voffA); PG8_STAGE(PG8_SA(0, 1), cA + hstep, voffA);
        if (wr == 1) PG8_BAR;
        PG8_WAIT_V(2); PG8_BAR;
        PG8_STAGE(PG8_SB(1, 0), cB + kstep, voffB); PG8_STAGE(PG8_SA(1, 0), cA + kstep, voffA); PG8_STAGE(PG8_SB(1, 1), cB + hstep + kstep, voffB);
        PG8_WAIT_V(6); PG8_BAR;
    } else {
        PG8_STAGE(PG8_SB(0, 0), cB, voffB); PG8_STAGE(PG8_SA(0, 0), cA, voffA); PG8_STAGE(PG8_SB(0, 1), cB + hstep, voffB); PG8_STAGE(PG8_SA(0, 1), cA + hstep, voffA);
        if (wr == 1) PG8_BAR;
        PG8_WAIT_V(4); PG8_BAR;
        PG8_STAGE(PG8_SB(1, 0), cB + kstep, voffB); PG8_STAGE(PG8_SA(1, 0), cA + kstep, voffA); PG8_STAGE(PG8_SB(1, 1), cB + hstep + kstep, voffB);
        PG8_WAIT_V(6); PG8_BAR;
    }
    for (;;) {
        const bool has_next = S.next(ui + 1, nxt);
        const char* nA = has_next ? (const char*)g.A + (size_t)nxt.pm * tstep : cA; const char* nB = has_next ? (const char*)g.Bt + (size_t)nxt.pn * tstep : cB;
        for (int t = 0; t < nt; t += 2) {
            const bool last = (t == nt - 2);
            const char* a1 = cA + (size_t)(t + 1) * kstep;
            const char* a2 = last ? nA : cA + (size_t)(t + 2) * kstep; const char* b2 = last ? nB : cB + (size_t)(t + 2) * kstep;
            const char* a3 = a2 + kstep; const char* b3 = b2 + kstep;
            if (last && has_next) S.a_ready(nxt);
            if constexpr (SP2) {
            PG8_LDB(B0, 0, 0); PG8_LDB(B1, 0, 1); PG8_SCHED; PG8_LDA(At, 0, 0); PG8_STAGE(PG8_SA(1, 1), a1 + hstep, voffA);
            PG8_WAIT_V(8); PG8_WAIT_L(0); PG8_BAR; PG8_MMA(0, 0, At, B0); PG8_MMA(0, 1, At, B1); PG8_BAR; PG8_SCHED;
            PG8_LDA(At, 0, 1); PG8_STAGE(PG8_SB(0, 0), b2, voffB); PG8_STAGE(PG8_SB(0, 1), b2 + hstep, voffB); PG8_STAGE(PG8_SA(0, 0), a2, voffA);
            PG8_WAIT_V(8); PG8_WAIT_L(0); PG8_BAR; PG8_MMA(1, 0, At, B0); PG8_MMA(1, 1, At, B1); PG8_BAR; PG8_SCHED;
            PG8_LDB(B0, 1, 0); PG8_LDB(B1, 1, 1); PG8_SCHED; PG8_LDA(At, 1, 0); PG8_STAGE(PG8_SA(0, 1), a2 + hstep, voffA);
            PG8_WAIT_V(8); PG8_WAIT_L(0); PG8_BAR; PG8_MMA(0, 0, At, B0); PG8_MMA(0, 1, At, B1); PG8_BAR; PG8_SCHED;
            PG8_LDA(At, 1, 1); PG8_STAGE(PG8_SB(1, 0), b3, voffB); PG8_STAGE(PG8_SB(1, 1), b3 + hstep, voffB); PG8_STAGE(PG8_SA(1, 0), a3, voffA);
            PG8_WAIT_V(8); PG8_WAIT_L(0); PG8_BAR; PG8_MMA(1, 0, At, B0); PG8_MMA(1, 1, At, B1); PG8_BAR; PG8_SCHED;
            } else {
            PG8_LDB(B0, 0, 0); PG8_SCHED; PG8_LDA(At, 0, 0); PG8_STAGE(PG8_SA(1, 1), a1 + hstep, voffA);
            PG8_WAIT_L(8); PG8_BAR; PG8_WAIT_L(0); PG8_MMA(0, 0, At, B0); PG8_BAR; PG8_SCHED;
            PG8_LDB(B1, 0, 1); PG8_STAGE(PG8_SB(0, 0), b2, voffB);
            PG8_BAR; PG8_WAIT_L(0); PG8_MMA(0, 1, At, B1); PG8_BAR;
            PG8_LDA(At, 0, 1); PG8_STAGE(PG8_SA(0, 0), a2, voffA);
            PG8_BAR; PG8_WAIT_L(0); PG8_MMA(1, 0, At, B0); PG8_BAR; PG8_SCHED;
            PG8_STAGE(PG8_SB(0, 1), b2 + hstep, voffB);
            PG8_WAIT_V(6); PG8_BAR; PG8_MMA(1, 1, At, B1); PG8_BAR;
            PG8_LDB(B0, 1, 0); PG8_SCHED; PG8_LDA(At, 1, 0); PG8_STAGE(PG8_SA(0, 1), a2 + hstep, voffA);
            PG8_WAIT_L(8); PG8_BAR; PG8_WAIT_L(0); PG8_MMA(0, 0, At, B0); PG8_BAR; PG8_SCHED;
            PG8_LDB(B1, 1, 1); PG8_STAGE(PG8_SB(1, 0), b3, voffB);
            PG8_BAR; PG8_WAIT_L(0); PG8_MMA(0, 1, At, B1); PG8_BAR;
            PG8_LDA(At, 1, 1); PG8_STAGE(PG8_SA(1, 0), a3, voffA);
            PG8_BAR; PG8_WAIT_L(0); PG8_MMA(1, 0, At, B0); PG8_BAR; PG8_SCHED;
            PG8_STAGE(PG8_SB(1, 1), b3 + hstep, voffB);
            PG8_WAIT_V(6); PG8_BAR; PG8_MMA(1, 1, At, B1); PG8_BAR;
            }
        }
        if constexpr (ALIGN_EPI) { if (wr == 0) PG8_BAR; }
        if constexpr (!Epi::AFTER_DRAIN) { E(acc, cur, wr, wc, fr, fq); S.done(cur); }
        if (!has_next) break;
#pragma unroll
        for (int a = 0; a < 2; ++a)
#pragma unroll
            for (int b = 0; b < 2; ++b)
#pragma unroll
                for (int m = 0; m < 4; ++m)
#pragma unroll
                    for (int n = 0; n < 2; ++n) acc[a][b][m][n] = (f32x4){0.f, 0.f, 0.f, 0.f};
        cur = nxt; cA = nA; cB = nB; ++ui;
        if constexpr (ALIGN_EPI) { if (wr == 1) PG8_BAR; }
    }
    PG8_WAIT_V(0);
    if constexpr (!ALIGN_EPI) { if (wr == 0) PG8_BAR; }
    PG8_BAR;
    if constexpr (Epi::AFTER_DRAIN) { E.fused(acc, cur, wr, wc, fr, fq, lds, wid, lane); S.done(cur); }
#undef PG8_SA
#undef PG8_SB
#undef PG8_STAGE
#undef PG8_LDA
#undef PG8_LDB
#undef PG8_MMA
#undef PG8_WAIT_V
#undef PG8_WAIT_L
#undef PG8_BAR
#undef PG8_SCHED
}
}

using pg8::bf16_t; using pg8::bf16x8; using pg8::f32x4; using pg8::u32x4; using pg8::u32x2; using pg8::pk2; using pg8::bflo; using pg8::bfhi; using pg8::siluf;
#define LAS __attribute__((address_space(3)))
typedef LAS unsigned char* lptr;
typedef short s16x4 __attribute__((ext_vector_type(4)));
typedef float f32x16 __attribute__((ext_vector_type(16)));
#define MFMA16(a, b, c) __builtin_amdgcn_mfma_f32_16x16x32_bf16((a), (b), (c), 0, 0, 0)
#define MFMA32(a, b, c) __builtin_amdgcn_mfma_f32_32x32x16_bf16((a), (b), (c), 0, 0, 0)

constexpr int T = 16384, SEQ = 2048, DM = 1024, FF = 2816, NWAVES = 8, NTHR = 512;
constexpr int LDS_BYTES = 147456;
constexpr size_t MiB = 1u << 20;
constexpr size_t WS_ROPEC = 0, WS_ROPES = 256 * 1024, WS_SSQ = 1 * MiB, WS_BD = 2 * MiB, WS_LSE = 3 * MiB;
constexpr size_t WS_WGU = 4 * MiB, WS_WD = 15 * MiB, WS_WIN = 21 * MiB, WS_WG = 32 * MiB, WS_WA = 38 * MiB, WS_WB = 39 * MiB, WS_WO = 41 * MiB;
constexpr size_t WS_XN = 44 * MiB, WS_HB = 76 * MiB;
constexpr size_t WS_QA = 76 * MiB, WS_KA = 100 * MiB, WS_VA = 124 * MiB, WS_QB = 148 * MiB, WS_KB = 180 * MiB, WS_VB = 212 * MiB, WS_YA = 244 * MiB, WS_CTL = 252 * MiB, WS_XB = 253 * MiB, WS_END = 254 * MiB;
constexpr size_t CTL_ZERO_BYTES = 65536;
constexpr int MISC_OFF = 143360;
static_assert(WS_KA - WS_QA == (24u << 20) && WS_KB - WS_QB == (32u << 20) && WS_VB - WS_KB == (32u << 20) && WS_HB + (size_t)T * FF * 2 <= WS_YA && WS_WD + (size_t)DM * FF * 2 <= WS_WIN && WS_WIN + (size_t)5632 * 1024 * 2 <= WS_WG, "ws map");

struct Args { const float* in[19]; float* out; unsigned char* ws; int ph_lo, ph_hi, probe, pad; };

__device__ __forceinline__ float wave_sum(float v) {
#pragma unroll
    for (int o = 1; o < 64; o <<= 1) v += __shfl_xor(v, o);
    return v;
}
__device__ __forceinline__ void conv_item(const float* W, int ldw, int kb, int src_col0, int nvalid, bf16_t* WT, int K, int dst_row0, LAS float* scr, int lane) {
    const int k0 = 64 * kb;
    float wv[32];
#pragma unroll
    for (int i = 0; i < 32; ++i) { const int kk = 2 * i + (lane >> 5), col = lane & 31; wv[i] = col < nvalid ? W[(size_t)(k0 + kk) * ldw + src_col0 + col] : 0.f; }
#pragma unroll
    for (int i = 0; i < 32; ++i) { const int kk = 2 * i + (lane >> 5), col = lane & 31; scr[kk * 33 + col] = wv[i]; }
    asm volatile("s_waitcnt lgkmcnt(0)" ::: "memory");
    const int c = lane & 7;
#pragma unroll
    for (int j = 0; j < 4; ++j) { const int n = (lane >> 3) + 8 * j; const LAS float* s = scr + (8 * c) * 33 + n;
        u32x4 o; o.x = pk2(s[0 * 33], s[1 * 33]); o.y = pk2(s[2 * 33], s[3 * 33]); o.z = pk2(s[4 * 33], s[5 * 33]); o.w = pk2(s[6 * 33], s[7 * 33]);
        *(u32x4*)(WT + (size_t)(dst_row0 + n) * K + k0 + 8 * c) = o; }
    asm volatile("s_waitcnt lgkmcnt(0)" ::: "memory");
}
__device__ __forceinline__ void conv_ffn_item(int it, const float* wg, const float* wu, const float* wd, bf16_t* WGU, bf16_t* WD, LAS float* scr, int lane) {
    if (it < 2816) { const int kb = it / 176, db = it % 176, pn = db >> 3, j = db & 7;
        conv_item(j < 4 ? wg : wu, FF, kb, 128 * pn + 32 * (j & 3), 32, WGU, DM, 32 * db, scr, lane); }
    else { it -= 2816; const int kb = it / 32, db = it % 32; conv_item(wd, DM, kb, 32 * db, 32, WD, FF, 32 * db, scr, lane); }
}
constexpr int FFN_ITEMS = 2816 + 1408;
constexpr int MIX_ITEMS = 2816 + 1536 + 128 + 512 + 512;
__device__ __forceinline__ void conv_mix_item(int it, const float* win, const float* wa, const float* wb, const float* wo, bf16_t* WIN, bf16_t* WG, bf16_t* WA, bf16_t* WB, bf16_t* WO, LAS float* scr, int lane) {
    if (it < 2816) { const int kb = it / 176, db = it % 176, tile = db >> 3, j = db & 7; int src, nv = 32;
        if (tile < 3 || (tile >= 16 && tile < 19)) { const int base = tile < 3 ? 0 : 768, tt = tile < 3 ? tile : tile - 16, hl = j & 3, bj = j >> 2; src = base + tt * 256 + 64 * hl + 32 * bj; }
        else if (tile < 15) src = 2304 + (tile - 3) * 256 + 32 * j;
        else if (tile == 15) { src = 5376; nv = j == 0 ? 16 : 0; }
        else src = 1536 + (tile - 19) * 256 + 32 * j;
        conv_item(win, 8464, kb, src, nv, WIN, DM, 32 * db, scr, lane); return; }
    it -= 2816;
    if (it < 1536) { const int kb = it / 96, db = it % 96; conv_item(win, 8464, kb, 5392 + 32 * db, 32, WG, DM, 32 * db, scr, lane); return; }
    it -= 1536;
    if (it < 128) { const int kb = it / 32, db = it % 32; conv_item(wa, DM, kb, 32 * db, 32, WA, 256, 32 * db, scr, lane); return; }
    it -= 128;
    if (it < 512) { const int kb = it / 32, db = it % 32; conv_item(wb, DM, kb, 32 * db, 32, WB, DM, 32 * db, scr, lane); return; }
    it -= 512;
    { const int kb = it / 32, db = it % 32; conv_item(wo, DM, kb, 32 * db, 32, WO, DM, 32 * db, scr, lane); }
}

constexpr int AT_KS = 144, AT_VS = 560, AT_VOFF = 272 * AT_KS;
__device__ __forceinline__ void attn_unit(lptr lds, bf16_t* QA, const bf16_t* KA, const bf16_t* VA, float* LSE, int u, int tid, bool dry) {
    const int lane = tid & 63, w = tid >> 6, q = lane & 15, quad = lane >> 4;
    const int b = u / 192, rem = u % 192, head = rem >> 4, sub = rem & 15, g = head >> 2;
    const int dsh = 2 * g, nbsh = 4 - dsh, r = sub >> nbsh, n = sub & ((1 << nbsh) - 1);
    {
        const int row = tid >> 1, half = tid & 1, idx = 128 * (n - 1) + row;
        u32x4 kv[4], vv[4];
        if (idx >= 0) { const size_t tok = (size_t)b * SEQ + ((size_t)idx << dsh) + r;
            const u32x4* kp = (const u32x4*)(KA + tok * 768 + head * 64 + half * 32); const u32x4* vp = (const u32x4*)(VA + tok * 768 + head * 64 + half * 32);
#pragma unroll
            for (int e = 0; e < 4; ++e) { kv[e] = kp[e]; vv[e] = vp[e]; } }
        else {
#pragma unroll
            for (int e = 0; e < 4; ++e) { kv[e] = (u32x4){0u, 0u, 0u, 0u}; vv[e] = (u32x4){0u, 0u, 0u, 0u}; } }
#pragma unroll
        for (int e = 0; e < 4; ++e) *(LAS u32x4*)(lds + row * AT_KS + half * 64 + e * 16) = kv[e];
#pragma unroll
        for (int e = 0; e < 4; ++e)
#pragma unroll
            for (int x = 0; x < 8; ++x) { const unsigned wv = vv[e][x >> 1]; const unsigned short val = (unsigned short)((x & 1) ? (wv >> 16) : (wv & 0xffffu));
                *(LAS unsigned short*)(lds + AT_VOFF + (half * 32 + e * 8 + x) * AT_VS + row * 2) = val; }
        if (tid < 144) *(LAS u32x4*)(lds + 256 * AT_KS + tid * 16) = (u32x4){0u, 0u, 0u, 0u};
        for (int e = tid; e < 768; e += NTHR) { const int dv = e / 12, k2 = e % 12; *(LAS unsigned*)(lds + AT_VOFF + dv * AT_VS + 512 + k2 * 4) = 0u; }
    }
    const size_t tq = (size_t)b * SEQ + ((size_t)(128 * n + 16 * w + q) << dsh) + r;
    bf16x8 qf[2];
#pragma unroll
    for (int s = 0; s < 2; ++s) qf[s] = *(const bf16x8*)(QA + tq * 768 + head * 64 + 32 * s + 8 * quad);
    __syncthreads();
    f32x4 S[9];
#pragma unroll
    for (int j = 0; j < 9; ++j) { S[j] = (f32x4){0.f, 0.f, 0.f, 0.f};
#pragma unroll
        for (int s = 0; s < 2; ++s) { const bf16x8 kf = *(const LAS bf16x8*)(lds + (16 * w + 16 * j + q) * AT_KS + (32 * s + 8 * quad) * 2); S[j] = MFMA16(kf, qf[s], S[j]); } }
    float m = -INFINITY;
#pragma unroll
    for (int j = 0; j < 9; ++j)
#pragma unroll
        for (int x = 0; x < 4; ++x) { const int rel = 16 * j + 4 * quad + x - q, kl = 16 * w + 16 * j + 4 * quad + x;
            const bool ok = rel >= 0 && rel <= 128 && (n > 0 || kl >= 128); const float s = ok ? S[j][x] : -INFINITY; S[j][x] = s; m = fmaxf(m, s); }
    m = fmaxf(m, __shfl_xor(m, 16)); m = fmaxf(m, __shfl_xor(m, 32));
    float l = 0.f;
#pragma unroll
    for (int j = 0; j < 9; ++j)
#pragma unroll
        for (int x = 0; x < 4; ++x) { const float p = __expf(S[j][x] - m); S[j][x] = p; l += p; }
    l += __shfl_xor(l, 16); l += __shfl_xor(l, 32);
    f32x4 O[4];
#pragma unroll
    for (int dt = 0; dt < 4; ++dt) O[dt] = (f32x4){0.f, 0.f, 0.f, 0.f};
#pragma unroll
    for (int ks = 0; ks < 5; ++ks) {
        u32x4 pw; pw.x = pk2(S[2 * ks][0], S[2 * ks][1]); pw.y = pk2(S[2 * ks][2], S[2 * ks][3]);
        if (2 * ks + 1 < 9) { pw.z = pk2(S[(2 * ks + 1) % 9][0], S[(2 * ks + 1) % 9][1]); pw.w = pk2(S[(2 * ks + 1) % 9][2], S[(2 * ks + 1) % 9][3]); } else { pw.z = 0u; pw.w = 0u; }
        const bf16x8 pb = __builtin_bit_cast(bf16x8, pw);
#pragma unroll
        for (int dt = 0; dt < 4; ++dt) { const lptr base = lds + AT_VOFF + (16 * dt + q) * AT_VS + (16 * w + 32 * ks + 4 * quad) * 2;
            const s16x4 lo = *(const LAS s16x4*)base, hi = *(const LAS s16x4*)(base + 32);
            const bf16x8 vf = __builtin_shufflevector(lo, hi, 0, 1, 2, 3, 4, 5, 6, 7); O[dt] = MFMA16(vf, pb, O[dt]); }
    }
    const float inv = 1.f / l;
#pragma unroll
    for (int dt = 0; dt < 4; ++dt) { u32x2 o; o.x = pk2(O[dt][0] * inv, O[dt][1] * inv); o.y = pk2(O[dt][2] * inv, O[dt][3] * inv);
        if (!dry) *(u32x2*)(QA + tq * 768 + head * 64 + 16 * dt + 4 * quad) = o; }
    if (quad == 0 && !dry) LSE[tq * 12 + head] = m + __logf(l);
    __syncthreads();
}

constexpr int KTS = 136;
constexpr int G_QS = 0, G_KS = 17408, G_KT = 34816, G_RT = 52224, G_OS = G_RT, G_WS = 87040, G_AS = 104448, G_MF = 113664, G_MN = 122880, G_TB = 125440, G_SM = 130560, G_CW = 131584, G_GN = 137728, G_END = 138240;
static_assert(G_END <= MISC_OFF && 64 * 528 <= G_WS - G_RT, "gdn lds");
__device__ __forceinline__ bf16x8 ld_krow(lptr rowp, int kbase, int hh) {
    const s16x4 lo = *(const LAS s16x4*)(rowp + (kbase + 4 * hh) * 2), hi = *(const LAS s16x4*)(rowp + (kbase + 8 + 4 * hh) * 2);
    return __builtin_shufflevector(lo, hi, 0, 1, 2, 3, 4, 5, 6, 7);
}
__device__ __forceinline__ bf16x8 ld_krow_sw(lptr rowp, int kbase, int hh, int sw) {
    const int g = (kbase >> 2) + hh;
    const s16x4 lo = *(const LAS s16x4*)(rowp + ((g ^ sw) << 3)), hi = *(const LAS s16x4*)(rowp + (((g + 2) ^ sw) << 3));
    return __builtin_shufflevector(lo, hi, 0, 1, 2, 3, 4, 5, 6, 7);
}
__device__ __forceinline__ bf16x8 ld_nat8_sw(lptr rowp, int j0, int sw) {
    const int g = j0 >> 2;
    const s16x4 lo = *(const LAS s16x4*)(rowp + ((g ^ sw) << 3)), hi = *(const LAS s16x4*)(rowp + (((g + 1) ^ sw) << 3));
    return __builtin_shufflevector(lo, hi, 0, 1, 2, 3, 4, 5, 6, 7);
}
__device__ __forceinline__ float row16_sum(float v) {
    v += __builtin_bit_cast(float, __builtin_amdgcn_update_dpp(0, __builtin_bit_cast(int, v), 0xB1, 0xF, 0xF, true));
    v += __builtin_bit_cast(float, __builtin_amdgcn_update_dpp(0, __builtin_bit_cast(int, v), 0x4E, 0xF, 0xF, true));
    v += __builtin_bit_cast(float, __builtin_amdgcn_update_dpp(0, __builtin_bit_cast(int, v), 0x141, 0xF, 0xF, true));
    v += __builtin_bit_cast(float, __builtin_amdgcn_update_dpp(0, __builtin_bit_cast(int, v), 0x140, 0xF, 0xF, true));
    return v;
}
#define PACK8(x, s) __builtin_bit_cast(bf16x8, (u32x4){pk2((x)[8 * (s)], (x)[8 * (s) + 1]), pk2((x)[8 * (s) + 2], (x)[8 * (s) + 3]), pk2((x)[8 * (s) + 4], (x)[8 * (s) + 5]), pk2((x)[8 * (s) + 6], (x)[8 * (s) + 7])})
#define OPQ(v) ({ int z_; asm volatile("v_mov_b32 %0, 0" : "=v"(z_)); (v) + z_; })
__device__ __forceinline__ float dpp_x1(float v) { return __builtin_bit_cast(float, __builtin_amdgcn_update_dpp(0, __builtin_bit_cast(int, v), 0xB1, 0xF, 0xF, true)); }
__device__ __forceinline__ float dpp_x2(float v) { return __builtin_bit_cast(float, __builtin_amdgcn_update_dpp(0, __builtin_bit_cast(int, v), 0x4E, 0xF, 0xF, true)); }
__device__ __forceinline__ void gdn_solve(lptr lds, int ct, int r, int hh, f32x16& X0, f32x16& X1) {
    const lptr rt = lds + G_RT + (32 * ct + r) * KTS; const int sw = (2 * ct + (r >> 4)) & 7;
    f32x16 z;
#pragma unroll
    for (int i = 0; i < 16; ++i) z[i] = 0.f;
    X0 = z;
#pragma unroll
    for (int s = 0; s < 2; ++s) { const bf16x8 a = *(const LAS bf16x8*)(lds + G_TB + r * 80 + (16 * s + 8 * hh) * 2); const bf16x8 bb = ld_nat8_sw(rt, 16 * s + 8 * hh, sw); X0 = MFMA32(a, bb, X0); }
    f32x16 Y;
#pragma unroll
    for (int g4 = 0; g4 < 4; ++g4) { const u32x2 rr = *(const LAS u32x2*)(rt + (((8 + 2 * g4 + hh) ^ sw) << 3)); Y[4 * g4] = bflo(rr.x); Y[4 * g4 + 1] = bfhi(rr.x); Y[4 * g4 + 2] = bflo(rr.y); Y[4 * g4 + 3] = bfhi(rr.y); }
#pragma unroll
    for (int s = 0; s < 2; ++s) { const bf16x8 a = ld_krow(lds + G_MN + r * 80, 16 * s, hh); Y = MFMA32(a, PACK8(X0, s), Y); }
    X1 = z;
#pragma unroll
    for (int s = 0; s < 2; ++s) { const bf16x8 a = ld_krow(lds + G_TB + 2560 + r * 80, 16 * s, hh); X1 = MFMA32(a, PACK8(Y, s), X1); }
}
__device__ __forceinline__ void gdn_pf_load(const bf16_t* X, long t0, bool first, int rg, int cg, u32x4 (&xv)[7]) {
#pragma unroll
    for (int k = 0; k < 7; ++k) { const int row = 4 * rg - 3 + k, rowc = (first && row < 0) ? 0 : row;
        xv[k] = *(const u32x4*)(X + (size_t)(t0 + rowc) * 1024 + 8 * cg); if (first && row < 0) xv[k] = (u32x4){0u, 0u, 0u, 0u}; }
}
typedef float f32x2v __attribute__((ext_vector_type(2)));
__device__ __forceinline__ void gdn_pf_comp(const u32x4 (&xv)[7], int cg, const LAS float* cwa, bool norm, float nscale, float (&out)[16]) {
    f32x2v w2[4][4];
#pragma unroll
    for (int tap = 0; tap < 4; ++tap) { const LAS f32x4* wp = (const LAS f32x4*)(cwa + tap * 384 + 8 * cg); const f32x4 wl = wp[0], wh = wp[1];
        w2[tap][0] = (f32x2v){wl[0], wl[1]}; w2[tap][1] = (f32x2v){wl[2], wl[3]}; w2[tap][2] = (f32x2v){wh[0], wh[1]}; w2[tap][3] = (f32x2v){wh[2], wh[3]}; }
#pragma unroll
    for (int rr = 0; rr < 4; ++rr) {
        f32x2v a2[4];
#pragma unroll
        for (int e = 0; e < 4; ++e) a2[e] = (f32x2v){0.f, 0.f};
#pragma unroll
        for (int tap = 0; tap < 4; ++tap) { const u32x4 x = xv[rr + tap];
#pragma unroll
            for (int e = 0; e < 4; ++e) { const unsigned wd = x[e]; const f32x2v xf = (f32x2v){bflo(wd), bfhi(wd)}; a2[e] = w2[tap][e] * xf + a2[e]; } }
        f32x2v ss2 = (f32x2v){0.f, 0.f};
#pragma unroll
        for (int e = 0; e < 4; ++e) { const f32x2v t = a2[e] * (-1.4426950408889634f); f32x2v ex; ex.x = __builtin_amdgcn_exp2f(t.x); ex.y = __builtin_amdgcn_exp2f(t.y);
            const f32x2v d = ex + 1.0f; f32x2v r; r.x = __builtin_amdgcn_rcpf(d.x); r.y = __builtin_amdgcn_rcpf(d.y); a2[e] = a2[e] * r; ss2 = a2[e] * a2[e] + ss2; }
        float sc = 1.f;
        if (norm) { const float ss = row16_sum(ss2.x + ss2.y); sc = rsqrtf(ss + 1e-6f) * nscale; }
#pragma unroll
        for (int e = 0; e < 4; ++e) { const f32x2v o = a2[e] * sc; out[4 * rr + e] = __builtin_bit_cast(float, pk2(o.x, o.y)); }
    }
}
__device__ __forceinline__ void gdn_chain(lptr lds, bf16_t* QB, const float* BD, const float* convw, const float* gnorm, int b, int h, int tid, bool dry) {
    const int lane = tid & 63, w = __builtin_amdgcn_readfirstlane(tid >> 6);
    LAS float* sm_gc = (LAS float*)(lds + G_SM); LAS float* sm_gam = sm_gc + 64; LAS float* sm_dk = sm_gc + 128; LAS float* sm_beta = sm_gc + 192;
    LAS float* cw = (LAS float*)(lds + G_CW);
    const bf16_t* Xq = QB + h * 128; const bf16_t* Xk = Xq + ((size_t)16 << 20); const bf16_t* Xv = Xq + ((size_t)32 << 20);
    __syncthreads();
    for (int e = tid; e < 1536; e += NTHR) { const int tap = e / 384, rem = e % 384, arr = rem >> 7, c = rem & 127; cw[e] = convw[tap * 3072 + arr * 1024 + h * 128 + c]; }
    if (tid < 128) ((LAS float*)(lds + G_GN))[tid] = gnorm[tid];
#define GDN_BDLOAD(tn) do { const int ln_ = OPQ(lane); bd_g = BD[((tn) + ln_) * 16 + 8 + h]; bd_b = BD[((tn) + ln_) * 16 + h]; } while (0)
#define GDN_SCAN() do { const int ln_ = OPQ(lane); float gi = bd_g; const float bt = bd_b; \
        _Pragma("unroll") for (int o = 1; o < 64; o <<= 1) { const float t_ = __shfl_up(gi, o); if (ln_ >= o) gi += t_; } S[3][0] = gi; S[3][1] = bt; } while (0)
#define GDN_TSCALE(src, dst, sb) do { _Pragma("unroll") for (int e = 0; e < 4; ++e) { const unsigned k0 = __builtin_bit_cast(unsigned, (src)[e]), k1 = __builtin_bit_cast(unsigned, (src)[4 + e]), k2 = __builtin_bit_cast(unsigned, (src)[8 + e]), k3 = __builtin_bit_cast(unsigned, (src)[12 + e]); \
        const float s0 = P[3][(sb)], s1 = P[3][(sb) + 1], s2 = P[3][(sb) + 2], s3 = P[3][(sb) + 3]; \
        (dst)[4 * e] = __builtin_bit_cast(float, pk2(bflo(k0) * s0, bflo(k1) * s1)); (dst)[4 * e + 1] = __builtin_bit_cast(float, pk2(bflo(k2) * s2, bflo(k3) * s3)); \
        (dst)[4 * e + 2] = __builtin_bit_cast(float, pk2(bfhi(k0) * s0, bfhi(k1) * s1)); (dst)[4 * e + 3] = __builtin_bit_cast(float, pk2(bfhi(k2) * s2, bfhi(k3) * s3)); } } while (0)
#define GBAR() do { asm volatile("s_waitcnt lgkmcnt(0)" ::: "memory"); __builtin_amdgcn_s_barrier(); asm volatile("" ::: "memory"); } while (0)
#define GDN_PFLOAD(tn, isfirst) do { const int t4_ = OPQ(tid) & 255, rg_ = t4_ >> 4, cg_ = t4_ & 15; \
        gdn_pf_load(Xq, (long)(tn), (isfirst), rg_, cg_, xq_); gdn_pf_load(Xk, (long)(tn), (isfirst), rg_, cg_, xk_); gdn_pf_load(Xv, (long)(tn), (isfirst), rg_, cg_, xv_); } while (0)
#define GDN_PFCOMP(xarr, arr) do { const int cg_ = OPQ(tid) & 15; gdn_pf_comp(xarr, cg_, cw + (arr) * 128, (arr) < 2, (arr) == 0 ? 0.08838834764831845f : 1.f, P[arr]); } while (0)
    __syncthreads();
    if (w < 4) {
        f32x16 S[4];
#pragma unroll
        for (int ct = 0; ct < 4; ++ct)
#pragma unroll
            for (int i = 0; i < 16; ++i) S[ct][i] = 0.f;
        for (int n = -1; n < 32; ++n) {
            const size_t t0 = (size_t)((long)b * SEQ + 64 * n);
            GBAR();
            GBAR();
            if (n >= 0) {
            const int lane_ = OPQ(lane), r = lane_ & 31, hh = lane_ >> 5;
            const int mat = w / 3, tt = w % 3, J = tt == 2 ? 1 : 0, I = tt == 0 ? 0 : 1;
            f32x16 acc, acc2;
#pragma unroll
            for (int i = 0; i < 16; ++i) { acc[i] = 0.f; acc2[i] = 0.f; }
#pragma unroll
            for (int s = 0; s < 8; s += 2) { const bf16x8 a = *(const LAS bf16x8*)(lds + G_KS + (32 * J + r) * 272 + (16 * s + 8 * hh) * 2), a2 = *(const LAS bf16x8*)(lds + G_KS + (32 * J + r) * 272 + (16 * s + 16 + 8 * hh) * 2);
                const bf16x8 bb = *(const LAS bf16x8*)(lds + (mat ? G_QS : G_KS) + (32 * I + r) * 272 + (16 * s + 8 * hh) * 2), bb2 = *(const LAS bf16x8*)(lds + (mat ? G_QS : G_KS) + (32 * I + r) * 272 + (16 * s + 16 + 8 * hh) * 2);
                acc = MFMA32(a, bb, acc); acc2 = MFMA32(a2, bb2, acc2); }
#pragma unroll
            for (int i = 0; i < 16; ++i) acc[i] += acc2[i];
            const int i = 32 * I + r; const float gi = sm_gc[i], bi = mat ? 1.f : sm_beta[i];
#pragma unroll
            for (int g4 = 0; g4 < 4; ++g4) { const int jb = 32 * J + 8 * g4 + 4 * hh; const f32x4 gj = *(const LAS f32x4*)(sm_gc + jb); f32x4 v;
#pragma unroll
                for (int x = 0; x < 4; ++x) { const int j = jb + x; const bool ok = mat ? (j <= i) : (j < i); v[x] = ok ? bi * __expf(gi - gj[x]) * acc[4 * g4 + x] : 0.f; }
                if (mat) { u32x2 o; o.x = pk2(v[0], v[1]); o.y = pk2(v[2], v[3]); *(LAS u32x2*)(lds + G_AS + i * 144 + jb * 2) = o; }
                else if (J == I) {
#pragma unroll
                    for (int x = 0; x < 4; ++x) *(LAS float*)(lds + G_MF + I * 4608 + r * 144 + x * 32 + (2 * g4 + hh) * 4) = v[x]; }
                else { u32x2 o; o.x = pk2(-v[0], -v[1]); o.y = pk2(-v[2], -v[3]); *(LAS u32x2*)(lds + G_MN + r * 80 + (8 * g4 + 4 * hh) * 2) = o; } }
            }
            GBAR();
            if (n >= 0) {
            const int lane_ = OPQ(lane), cl = lane_ >> 2, p = lane_ & 3, blk = w >> 1, c = 16 * (w & 1) + cl;
            const lptr mp = lds + G_MF + blk * 4608 + p * 32; float tm[8];
#pragma unroll
            for (int k = 0; k < 8; ++k) tm[k] = 0.f;
            f32x4 ma[2][4], mb[2][4];
#pragma unroll
            for (int q4 = 0; q4 < 4; ++q4) { ma[0][q4] = *(const LAS f32x4*)(mp + q4 * 144); mb[0][q4] = (f32x4){0.f, 0.f, 0.f, 0.f}; }
#pragma unroll
            for (int bk = 0; bk < 8; ++bk) {
                if (bk < 7) {
#pragma unroll
                    for (int q4 = 0; q4 < 4; ++q4) { const int i = 4 * (bk + 1) + q4; ma[(bk + 1) & 1][q4] = *(const LAS f32x4*)(mp + i * 144);
                        if (i > 16) mb[(bk + 1) & 1][q4] = *(const LAS f32x4*)(mp + i * 144 + 16); else mb[(bk + 1) & 1][q4] = (f32x4){0.f, 0.f, 0.f, 0.f}; }
                }
                asm volatile("" ::: "memory");
#pragma unroll
                for (int q4 = 0; q4 < 4; ++q4) { const int i = 4 * bk + q4; const f32x4 m0 = ma[bk & 1][q4], m1 = mb[bk & 1][q4];
                    float acc = (i == c && p == 0) ? 1.f : 0.f;
                    if (i > 0) acc -= m0[0] * tm[0]; if (i > 4) acc -= m0[1] * tm[1]; if (i > 8) acc -= m0[2] * tm[2]; if (i > 12) acc -= m0[3] * tm[3];
                    if (i > 16) acc -= m1[0] * tm[4]; if (i > 20) acc -= m1[1] * tm[5]; if (i > 24) acc -= m1[2] * tm[6]; if (i > 28) acc -= m1[3] * tm[7];
                    acc += dpp_x1(acc); acc += dpp_x2(acc);
                    tm[i >> 2] = (p == (i & 3)) ? acc : tm[i >> 2]; }
            }
#pragma unroll
            for (int k = 0; k < 8; ++k) *(LAS unsigned short*)(lds + G_TB + blk * 2560 + (4 * k + p) * 80 + c * 2) = (unsigned short)pk2(tm[k], 0.f);
            }
            GBAR();
            f32x16 U0, U1;
            if (n >= 0) {
            const int lane_ = OPQ(lane), r = lane_ & 31, hh = lane_ >> 5;
            f32x16 W0, W1;
            gdn_solve(lds, 4 + w, r, hh, W0, W1);
#pragma unroll
            for (int i = 0; i < 16; ++i) { const int row = (i & 3) + 8 * (i >> 2) + 4 * hh;
                *(LAS unsigned short*)(lds + G_WS + row * 272 + (32 * w + r) * 2) = (unsigned short)pk2(-W0[i], 0.f);
                *(LAS unsigned short*)(lds + G_WS + (32 + row) * 272 + (32 * w + r) * 2) = (unsigned short)pk2(-W1[i], 0.f); }
            gdn_solve(lds, w, r, hh, U0, U1);
            }
            GBAR();
            if (n >= 0) {
            const int lane_ = OPQ(lane), r = lane_ & 31, hh = lane_ >> 5;
            bf16x8 Sp[4][2];
#pragma unroll
            for (int ct = 0; ct < 4; ++ct) { Sp[ct][0] = PACK8(S[ct], 0); Sp[ct][1] = PACK8(S[ct], 1); }
            f32x16 O0, O1;
#pragma unroll
            for (int i = 0; i < 16; ++i) { O0[i] = 0.f; O1[i] = 0.f; }
#pragma unroll
            for (int ct = 0; ct < 4; ++ct)
#pragma unroll
                for (int s = 0; s < 2; ++s) {
                    U0 = MFMA32(ld_krow(lds + G_WS + r * 272, 32 * ct + 16 * s, hh), Sp[ct][s], U0);
                    U1 = MFMA32(ld_krow(lds + G_WS + (32 + r) * 272, 32 * ct + 16 * s, hh), Sp[ct][s], U1);
                    O0 = MFMA32(ld_krow(lds + G_QS + r * 272, 32 * ct + 16 * s, hh), Sp[ct][s], O0);
                    O1 = MFMA32(ld_krow(lds + G_QS + (32 + r) * 272, 32 * ct + 16 * s, hh), Sp[ct][s], O1);
                }
#pragma unroll
            for (int g4 = 0; g4 < 4; ++g4) { const f32x4 ga = *(const LAS f32x4*)(sm_gam + 8 * g4 + 4 * hh), gb = *(const LAS f32x4*)(sm_gam + 32 + 8 * g4 + 4 * hh);
#pragma unroll
                for (int x = 0; x < 4; ++x) { O0[4 * g4 + x] *= ga[x]; O1[4 * g4 + x] *= gb[x]; } }
            {
                const bf16x8 v00 = PACK8(U0, 0), v01 = PACK8(U0, 1), v10 = PACK8(U1, 0), v11 = PACK8(U1, 1);
                O0 = MFMA32(ld_krow(lds + G_AS + r * 144, 0, hh), v00, O0); O0 = MFMA32(ld_krow(lds + G_AS + r * 144, 16, hh), v01, O0);
                O1 = MFMA32(ld_krow(lds + G_AS + (32 + r) * 144, 0, hh), v00, O1); O1 = MFMA32(ld_krow(lds + G_AS + (32 + r) * 144, 16, hh), v01, O1);
                O1 = MFMA32(ld_krow(lds + G_AS + (32 + r) * 144, 32, hh), v10, O1); O1 = MFMA32(ld_krow(lds + G_AS + (32 + r) * 144, 48, hh), v11, O1);
            }
#pragma unroll
            for (int g4 = 0; g4 < 4; ++g4) { const f32x4 da = *(const LAS f32x4*)(sm_dk + 8 * g4 + 4 * hh), db = *(const LAS f32x4*)(sm_dk + 32 + 8 * g4 + 4 * hh);
#pragma unroll
                for (int x = 0; x < 4; ++x) { U0[4 * g4 + x] *= da[x]; U1[4 * g4 + x] *= db[x]; } }
            const bf16x8 s00 = PACK8(U0, 0), s01 = PACK8(U0, 1), s10 = PACK8(U1, 0), s11 = PACK8(U1, 1);
            const float glast = sm_gam[63];
#pragma unroll
            for (int ct = 0; ct < 4; ++ct) {
#pragma unroll
                for (int i = 0; i < 16; ++i) S[ct][i] *= glast;
                const lptr kt = lds + G_KT + (32 * ct + r) * KTS; const int sw = (2 * ct + (r >> 4)) & 7;
                S[ct] = MFMA32(ld_krow_sw(kt, 0, hh, sw), s00, S[ct]); S[ct] = MFMA32(ld_krow_sw(kt, 16, hh, sw), s01, S[ct]);
                S[ct] = MFMA32(ld_krow_sw(kt, 32, hh, sw), s10, S[ct]); S[ct] = MFMA32(ld_krow_sw(kt, 48, hh, sw), s11, S[ct]);
            }
#pragma unroll
            for (int i = 0; i < 16; ++i) { const int row = (i & 3) + 8 * (i >> 2) + 4 * hh;
                *(LAS float*)(lds + G_OS + row * 528 + (32 * w + r) * 4) = O0[i]; *(LAS float*)(lds + G_OS + (32 + row) * 528 + (32 * w + r) * 4) = O1[i]; }
            }
            GBAR();
        if (n >= 0) {
            const int tid_ = OPQ(tid), ri = tid_ >> 3, cs = tid_ & 7, c0 = 16 * cs;
            const LAS f32x4* op = (const LAS f32x4*)(lds + G_OS + ri * 528 + c0 * 4); f32x4 o[4]; float ss = 0.f;
#pragma unroll
            for (int e = 0; e < 4; ++e) { o[e] = op[e]; ss += (o[e][0] * o[e][0] + o[e][1] * o[e][1]) + (o[e][2] * o[e][2] + o[e][3] * o[e][3]); }
            ss += __shfl_xor(ss, 1); ss += __shfl_xor(ss, 2); ss += __shfl_xor(ss, 4);
            const float rs = rsqrtf(ss * (1.f / 128.f) + 1e-6f);
            unsigned pw[8];
#pragma unroll
            for (int e = 0; e < 4; ++e) { const f32x4 gn = *(const LAS f32x4*)(lds + G_GN + (c0 + 4 * e) * 4); pw[2 * e] = pk2(o[e][0] * rs * gn[0], o[e][1] * rs * gn[1]); pw[2 * e + 1] = pk2(o[e][2] * rs * gn[2], o[e][3] * rs * gn[3]); }
            u32x4* dst = (u32x4*)(QB + (t0 + ri) * 1024 + h * 128 + c0);
            if (!dry) { dst[0] = (u32x4){pw[0], pw[1], pw[2], pw[3]}; dst[1] = (u32x4){pw[4], pw[5], pw[6], pw[7]}; }
        }
        }
    } else {
        float P[5][16];
#define S P
        u32x4 xq_[7], xk_[7], xv_[7];
        float bd_g, bd_b;
        GDN_PFLOAD((size_t)b * SEQ, true); GDN_BDLOAD((size_t)b * SEQ);
        for (int n = -1; n < 32; ++n) {
            const size_t t0 = (size_t)((long)b * SEQ + 64 * n);
            GBAR();
            if (n >= 0) {
            const int t4 = OPQ(tid) & 255, rg = t4 >> 4, cg = t4 & 15, ln = t4 & 63;
            const float gcv = S[3][0], btv = S[3][1];
            if (w == 4) { sm_gc[ln] = gcv; sm_gam[ln] = P[3][10]; sm_dk[ln] = P[3][11]; sm_beta[ln] = btv; }
#pragma unroll
            for (int rr = 0; rr < 4; ++rr) {
                *(LAS u32x4*)(lds + G_QS + (4 * rg + rr) * 272 + cg * 16) = (u32x4){__builtin_bit_cast(unsigned, P[0][4 * rr]), __builtin_bit_cast(unsigned, P[0][4 * rr + 1]), __builtin_bit_cast(unsigned, P[0][4 * rr + 2]), __builtin_bit_cast(unsigned, P[0][4 * rr + 3])};
                *(LAS u32x4*)(lds + G_KS + (4 * rg + rr) * 272 + cg * 16) = (u32x4){__builtin_bit_cast(unsigned, P[1][4 * rr]), __builtin_bit_cast(unsigned, P[1][4 * rr + 1]), __builtin_bit_cast(unsigned, P[1][4 * rr + 2]), __builtin_bit_cast(unsigned, P[1][4 * rr + 3])};
            }
            const int swk = (cg >> 1) & 7, slot = (rg ^ swk) << 3;
#pragma unroll
            for (int e = 0; e < 4; ++e) {
                const unsigned k0 = __builtin_bit_cast(unsigned, P[1][e]), k1 = __builtin_bit_cast(unsigned, P[1][4 + e]), k2 = __builtin_bit_cast(unsigned, P[1][8 + e]), k3 = __builtin_bit_cast(unsigned, P[1][12 + e]);
                const int c = 8 * cg + 2 * e;
                *(LAS u32x2*)(lds + G_KT + c * KTS + slot) = (u32x2){(k0 & 0xffffu) | (k1 << 16), (k2 & 0xffffu) | (k3 << 16)};
                *(LAS u32x2*)(lds + G_KT + (c + 1) * KTS + slot) = (u32x2){(k0 >> 16) | (k1 & 0xffff0000u), (k2 >> 16) | (k3 & 0xffff0000u)};
                *(LAS u32x2*)(lds + G_RT + (128 + c) * KTS + slot) = (u32x2){__builtin_bit_cast(unsigned, P[4][4 * e]), __builtin_bit_cast(unsigned, P[4][4 * e + 1])};
                *(LAS u32x2*)(lds + G_RT + (129 + c) * KTS + slot) = (u32x2){__builtin_bit_cast(unsigned, P[4][4 * e + 2]), __builtin_bit_cast(unsigned, P[4][4 * e + 3])};
                *(LAS u32x2*)(lds + G_RT + c * KTS + slot) = (u32x2){__builtin_bit_cast(unsigned, P[2][4 * e]), __builtin_bit_cast(unsigned, P[2][4 * e + 1])};
                *(LAS u32x2*)(lds + G_RT + (c + 1) * KTS + slot) = (u32x2){__builtin_bit_cast(unsigned, P[2][4 * e + 2]), __builtin_bit_cast(unsigned, P[2][4 * e + 3])};
            }
            }
            GBAR();
            if (n >= 0 && w < 6) {
            const int lane_ = OPQ(lane), r = lane_ & 31, hh = lane_ >> 5;
            const int mat = w / 3, tt = w % 3, J = tt == 2 ? 1 : 0, I = tt == 0 ? 0 : 1;
            f32x16 acc, acc2;
#pragma unroll
            for (int i = 0; i < 16; ++i) { acc[i] = 0.f; acc2[i] = 0.f; }
#pragma unroll
            for (int s = 0; s < 8; s += 2) { const bf16x8 a = *(const LAS bf16x8*)(lds + G_KS + (32 * J + r) * 272 + (16 * s + 8 * hh) * 2), a2 = *(const LAS bf16x8*)(lds + G_KS + (32 * J + r) * 272 + (16 * s + 16 + 8 * hh) * 2);
                const bf16x8 bb = *(const LAS bf16x8*)(lds + (mat ? G_QS : G_KS) + (32 * I + r) * 272 + (16 * s + 8 * hh) * 2), bb2 = *(const LAS bf16x8*)(lds + (mat ? G_QS : G_KS) + (32 * I + r) * 272 + (16 * s + 16 + 8 * hh) * 2);
                acc = MFMA32(a, bb, acc); acc2 = MFMA32(a2, bb2, acc2); }
#pragma unroll
            for (int i = 0; i < 16; ++i) acc[i] += acc2[i];
            const int i = 32 * I + r; const float gi = sm_gc[i], bi = mat ? 1.f : sm_beta[i];
#pragma unroll
            for (int g4 = 0; g4 < 4; ++g4) { const int jb = 32 * J + 8 * g4 + 4 * hh; const f32x4 gj = *(const LAS f32x4*)(sm_gc + jb); f32x4 v;
#pragma unroll
                for (int x = 0; x < 4; ++x) { const int j = jb + x; const bool ok = mat ? (j <= i) : (j < i); v[x] = ok ? bi * __expf(gi - gj[x]) * acc[4 * g4 + x] : 0.f; }
                if (mat) { u32x2 o; o.x = pk2(v[0], v[1]); o.y = pk2(v[2], v[3]); *(LAS u32x2*)(lds + G_AS + i * 144 + jb * 2) = o; }
                else if (J == I) {
#pragma unroll
                    for (int x = 0; x < 4; ++x) *(LAS float*)(lds + G_MF + I * 4608 + r * 144 + x * 32 + (2 * g4 + hh) * 4) = v[x]; }
                else { u32x2 o; o.x = pk2(-v[0], -v[1]); o.y = pk2(-v[2], -v[3]); *(LAS u32x2*)(lds + G_MN + r * 80 + (8 * g4 + 4 * hh) * 2) = o; } }
            }
            GBAR();
            if (n < 31) { GDN_SCAN();
                { const int rg_ = (OPQ(tid) & 255) >> 4; const float gi_ = P[3][0], bt_ = P[3][1], gl_ = __shfl(gi_, 63); P[3][10] = __expf(gi_); P[3][11] = __expf(gl_ - gi_);
#pragma unroll
                  for (int rr = 0; rr < 4; ++rr) { const float be_ = __shfl(bt_, 4 * rg_ + rr); P[3][2 + rr] = be_; P[3][6 + rr] = be_ * __expf(__shfl(gi_, 4 * rg_ + rr)); } }
                GDN_PFCOMP(xq_, 0); }
            GBAR();
            if (n < 31) { GDN_PFCOMP(xk_, 1); GDN_TSCALE(P[1], P[4], 6); }
            GBAR();
            if (n < 31) { float tv_[16]; { const int cg_ = OPQ(tid) & 15; gdn_pf_comp(xv_, cg_, cw + 256, false, 1.f, tv_); } GDN_TSCALE(tv_, P[2], 2); }
            if (n < 30) { GDN_PFLOAD(t0 + 128, false); GDN_BDLOAD(t0 + 128); }
            GBAR();
        if (n >= 0) {
            const int tid_ = OPQ(tid), ri = tid_ >> 3, cs = tid_ & 7, c0 = 16 * cs;
            const LAS f32x4* op = (const LAS f32x4*)(lds + G_OS + ri * 528 + c0 * 4); f32x4 o[4]; float ss = 0.f;
#pragma unroll
            for (int e = 0; e < 4; ++e) { o[e] = op[e]; ss += (o[e][0] * o[e][0] + o[e][1] * o[e][1]) + (o[e][2] * o[e][2] + o[e][3] * o[e][3]); }
            ss += __shfl_xor(ss, 1); ss += __shfl_xor(ss, 2); ss += __shfl_xor(ss, 4);
            const float rs = rsqrtf(ss * (1.f / 128.f) + 1e-6f);
            unsigned pw[8];
#pragma unroll
            for (int e = 0; e < 4; ++e) { const f32x4 gn = *(const LAS f32x4*)(lds + G_GN + (c0 + 4 * e) * 4); pw[2 * e] = pk2(o[e][0] * rs * gn[0], o[e][1] * rs * gn[1]); pw[2 * e + 1] = pk2(o[e][2] * rs * gn[2], o[e][3] * rs * gn[3]); }
            u32x4* dst = (u32x4*)(QB + (t0 + ri) * 1024 + h * 128 + c0);
            if (!dry) { dst[0] = (u32x4){pw[0], pw[1], pw[2], pw[3]}; dst[1] = (u32x4){pw[4], pw[5], pw[6], pw[7]}; }
        }
        }
#undef S
    }
    __syncthreads();
#undef GDN_SCAN
#undef GDN_BDLOAD
#undef GDN_PFLOAD
#undef GDN_PFCOMP
#undef GBAR
#undef GDN_TSCALE
}

typedef unsigned v4u_unused_t;
#define XB_TMO      128
#define XB_XCNT(j)  (256  + 64 * (j))
#define XB_XSUB(j)  (1280 + 64 * (j))
#define XB_XGEN(j)  (2304 + 64 * (j))
#define XB_TOP      3328
#define XB_TOPGEN   3392
#define XCD_BAR_WORDS 3456
#define XB_SPIN_CAP (1u << 18)

__device__ __forceinline__ unsigned xb_ld(unsigned* p)              { return __hip_atomic_load(p, __ATOMIC_RELAXED, __HIP_MEMORY_SCOPE_AGENT); }
__device__ __forceinline__ unsigned xb_add(unsigned* p, unsigned v) { return __hip_atomic_fetch_add(p, v, __ATOMIC_RELAXED, __HIP_MEMORY_SCOPE_AGENT); }
__device__ __forceinline__ unsigned xb_xcc_id() { return (unsigned)__builtin_amdgcn_s_getreg((3 << 11) | 20) & 0xFu; }
#define XB_SPIN(cond, bar) do { unsigned _sp = 0; while (cond) { __builtin_amdgcn_s_sleep(1); \
    if ((++_sp & 255u) == 0u) { if (xb_ld(&(bar)[XB_TMO])) break; if (_sp > XB_SPIN_CAP) { atomicAdd(&(bar)[XB_TMO], 1u); break; } } } } while (0)

struct XcdBarrier {
    unsigned* bar; unsigned x;
    volatile LAS unsigned* st;
};

__device__ __forceinline__ XcdBarrier xcd_barrier_post(unsigned* bar, volatile LAS unsigned* st) {
    XcdBarrier b; b.bar = bar; b.x = xb_xcc_id(); b.st = st;
    if (threadIdx.x == 0) (void)xb_add(&bar[XB_XCNT(b.x)], 1u);
    return b;
}
__device__ __forceinline__ void xcd_barrier_complete(unsigned* bar, unsigned x, unsigned& nloc, unsigned& nx) {
    const unsigned G = gridDim.x * gridDim.y * gridDim.z;
    unsigned sum, cnt, mine, sp = 0u;
    for (;;) {
        sum = 0u; cnt = 0u; mine = 0u;
#pragma unroll
        for (unsigned j = 0; j < 16; ++j) { const unsigned c = xb_ld(&bar[XB_XCNT(j)]); sum += c; cnt += (c > 0u) ? 1u : 0u; mine = (j == x) ? c : mine; }
        if (sum == G) break;
        __builtin_amdgcn_s_sleep(1);
        if ((++sp & 255u) == 0u) { if (xb_ld(&bar[XB_TMO])) break; if (sp > XB_SPIN_CAP) { atomicAdd(&bar[XB_TMO], 1u); break; } }
    }
    nloc = mine > 0u ? mine : 1u; nx = cnt > 0u ? cnt : 1u;
}

__device__ __forceinline__ void xcd_barrier(const XcdBarrier& b) {
    asm volatile("s_waitcnt vmcnt(0)" ::: "memory");
    __syncthreads();
    if (threadIdx.x == 0) {
        unsigned* bar = b.bar;
        __builtin_amdgcn_s_waitcnt(0);
        unsigned nloc = b.st[0], nx = b.st[1];
        if (nloc == 0u) { xcd_barrier_complete(bar, b.x, nloc, nx); b.st[0] = nloc; b.st[1] = nx; }
        const unsigned old = xb_add(&bar[XB_XSUB(b.x)], 1u);
        const unsigned gen = old / nloc;
        if (old + 1u == (gen + 1u) * nloc) {
            __builtin_amdgcn_fence(__ATOMIC_RELEASE, "agent");
            asm volatile("s_waitcnt vmcnt(0)" ::: "memory");
            const unsigned og = xb_add(&bar[XB_TOP], 1u);
            const unsigned tg = og / nx;
            if (og + 1u == (tg + 1u) * nx) xb_add(&bar[XB_TOPGEN], 1u);
            else XB_SPIN(xb_ld(&bar[XB_TOPGEN]) == tg, bar);
            __builtin_amdgcn_fence(__ATOMIC_ACQUIRE, "agent");
            xb_add(&bar[XB_XGEN(b.x)], 1u);
            asm volatile("s_waitcnt vmcnt(0)" ::: "memory");
        } else {
            XB_SPIN(xb_ld(&bar[XB_XGEN(b.x)]) == gen, bar);
            __builtin_amdgcn_fence(__ATOMIC_ACQUIRE, "agent");
            asm volatile("s_waitcnt vmcnt(0)" ::: "memory");
        }
    }
    __syncthreads();
}

__device__ __forceinline__ void sub_barrier(unsigned* ctr, unsigned nwg, unsigned& round) {
    asm volatile("s_waitcnt vmcnt(0)" ::: "memory");
    __syncthreads();
    if (threadIdx.x == 0) {
        __threadfence();
        asm volatile("s_waitcnt vmcnt(0)" ::: "memory");
        const unsigned target = (round + 1u) * nwg;
        __hip_atomic_fetch_add(ctr, 1u, __ATOMIC_RELAXED, __HIP_MEMORY_SCOPE_AGENT);
        unsigned sp = 0;
        while (__hip_atomic_load(ctr, __ATOMIC_RELAXED, __HIP_MEMORY_SCOPE_AGENT) < target) { __builtin_amdgcn_s_sleep(4); if (++sp > (1u << 24)) break; }
        __builtin_amdgcn_fence(__ATOMIC_ACQUIRE, "agent");
        asm volatile("s_waitcnt vmcnt(0)" ::: "memory");
    }
    __syncthreads();
    ++round;
}

__device__ __forceinline__ void merge_groups(const bf16_t* QA, const float* LSE, bf16_t* YA, int first, int nwg, int tid) {
        for (int e = first * NTHR + tid; e < T * 32; e += nwg * NTHR) { const int t = e >> 5, hs = (e >> 3) & 3, c8 = e & 7;
            const float l0 = LSE[(size_t)t * 12 + hs], l1 = LSE[(size_t)t * 12 + 4 + hs], l2 = LSE[(size_t)t * 12 + 8 + hs]; const float mx = fmaxf(l0, fmaxf(l1, l2));
            float w0 = __expf(l0 - mx), w1 = __expf(l1 - mx), w2 = __expf(l2 - mx); const float inv = 1.f / (w0 + w1 + w2); w0 *= inv; w1 *= inv; w2 *= inv;
            const bf16_t* op = QA + (size_t)t * 768 + hs * 64 + c8 * 8; const u32x4 o0 = *(const u32x4*)op, o1 = *(const u32x4*)(op + 256), o2 = *(const u32x4*)(op + 512); u32x4 y;
            y.x = pk2(w0 * bflo(o0.x) + w1 * bflo(o1.x) + w2 * bflo(o2.x), w0 * bfhi(o0.x) + w1 * bfhi(o1.x) + w2 * bfhi(o2.x));
            y.y = pk2(w0 * bflo(o0.y) + w1 * bflo(o1.y) + w2 * bflo(o2.y), w0 * bfhi(o0.y) + w1 * bfhi(o1.y) + w2 * bfhi(o2.y));
            y.z = pk2(w0 * bflo(o0.z) + w1 * bflo(o1.z) + w2 * bflo(o2.z), w0 * bfhi(o0.z) + w1 * bfhi(o1.z) + w2 * bfhi(o2.z));
            y.w = pk2(w0 * bflo(o0.w) + w1 * bflo(o1.w) + w2 * bflo(o2.w), w0 * bfhi(o0.w) + w1 * bfhi(o1.w) + w2 * bfhi(o2.w));
            *(u32x4*)(YA + (size_t)t * 256 + hs * 64 + c8 * 8) = y; }
}

__global__ void __launch_bounds__(NTHR, 2) mk_fwd(Args args) {
    extern __shared__ __attribute__((aligned(16))) unsigned char lds_raw[];
    cg::grid_group grid = cg::this_grid();
    const lptr lds = (lptr)lds_raw;
    const int tid = threadIdx.x, lane = tid & 63, wave = __builtin_amdgcn_readfirstlane(tid >> 6);
    const int G = gridDim.x, bid = blockIdx.x;
    const int gw = bid * NWAVES + wave, NGW = G * NWAVES;
    unsigned char* ws = args.ws;
    const float* x = args.in[0];
    const float *ffn1_norm = args.in[1], *f1g = args.in[2], *f1u = args.in[3], *f1d = args.in[4], *mix_norm = args.in[5], *w_in = args.in[6], *convw = args.in[7], *a_log = args.in[8], *dt_bias = args.in[9],
                *gnorm = args.in[10], *w_a = args.in[11], *w_b = args.in[12], *w_o = args.in[13], *ffn2_norm = args.in[14], *f2g = args.in[15], *f2u = args.in[16], *f2d = args.in[17], *final_norm = args.in[18];
    float* out = args.out;
    float* ROPEC = (float*)(ws + WS_ROPEC); float* ROPES = (float*)(ws + WS_ROPES); float* SSQ = (float*)(ws + WS_SSQ); float* BD = (float*)(ws + WS_BD); float* LSE = (float*)(ws + WS_LSE);
    bf16_t *WGU = (bf16_t*)(ws + WS_WGU), *WD = (bf16_t*)(ws + WS_WD), *WIN = (bf16_t*)(ws + WS_WIN), *WG = (bf16_t*)(ws + WS_WG), *WA = (bf16_t*)(ws + WS_WA), *WB = (bf16_t*)(ws + WS_WB), *WO = (bf16_t*)(ws + WS_WO);
    bf16_t *XN = (bf16_t*)(ws + WS_XN), *HB = (bf16_t*)(ws + WS_HB), *QA = (bf16_t*)(ws + WS_QA), *KA = (bf16_t*)(ws + WS_KA), *VA = (bf16_t*)(ws + WS_VA), *QB = (bf16_t*)(ws + WS_QB), *KB = (bf16_t*)(ws + WS_KB), *VB = (bf16_t*)(ws + WS_VB), *YA = (bf16_t*)(ws + WS_YA);
    bf16_t* GA_ = (bf16_t*)(ws + WS_QA); bf16_t* GB_ = (bf16_t*)(ws + WS_QA + (32u << 20));
    const int lo = args.ph_lo, hi = args.ph_hi;
    volatile LAS unsigned* MISC = (volatile LAS unsigned*)(lds + MISC_OFF);
    if (tid < 16) MISC[tid] = 0u;
    __syncthreads();
    XcdBarrier bar = xcd_barrier_post((unsigned*)(ws + WS_CTL), MISC);
    if (args.probe == 0x7fffffff) grid.sync();
#define IN(k) (lo <= (k) && (k) < hi)
#define SEAM(k) do { if (IN(k) && IN((k) + 1)) { xcd_barrier(bar); if (args.probe & 1) xcd_barrier(bar); } } while (0)
    LAS float* scr = (LAS float*)(lds + wave * 8448);

    if (IN(0)) {
        const int n_now = (G == 256) ? 2816 : FFN_ITEMS;
        for (int it = gw; it < n_now; it += NGW) conv_ffn_item(it, f1g, f1u, f1d, WGU, WD, scr, lane);
        if (G != 256) for (int it = gw; it < MIX_ITEMS; it += NGW) conv_mix_item(it, w_in, w_a, w_b, w_o, WIN, WG, WA, WB, WO, scr, lane);
        for (int e = bid * NTHR + tid; e < SEQ * 32; e += G * NTHR) { const int pos = e >> 5, d = e & 31;
            const float invf = exp2f(-(float)d * (13.287712379549449f / 32.f)); const float ang = (float)pos * invf;
            const double a = (double)ang, k = rint(a * 0.15915494309189535); const float rr = (float)(a - k * 6.283185307179586);
            ROPEC[e] = __cosf(rr); ROPES[e] = __sinf(rr); }
        for (int m0 = gw; m0 < T; m0 += 4 * NGW) {
            f32x4 v[4][4];
#pragma unroll
            for (int q = 0; q < 4; ++q) { const int m = m0 + q * NGW; if (m < T) { const f32x4* xr = (const f32x4*)(x + (size_t)m * DM) + lane;
#pragma unroll
                for (int j = 0; j < 4; ++j) v[q][j] = xr[64 * j]; } }
#pragma unroll
            for (int q = 0; q < 4; ++q) { const int m = m0 + q * NGW; if (m < T) { float s = 0.f; u32x2* o8 = (u32x2*)(XN + (size_t)m * DM) + lane;
#pragma unroll
                for (int j = 0; j < 4; ++j) { const f32x4 g = *((const f32x4*)ffn1_norm + lane + 64 * j); const f32x4 vv = v[q][j]; s += (vv[0] * vv[0] + vv[1] * vv[1]) + (vv[2] * vv[2] + vv[3] * vv[3]);
                    u32x2 w; w.x = pk2(vv[0] * g[0], vv[1] * g[1]); w.y = pk2(vv[2] * g[2], vv[3] * g[3]); o8[64 * j] = w; }
                s = wave_sum(s); if (lane < 16) SSQ[(size_t)m * 16 + lane] = lane == 0 ? s : 0.f; } }
        }
    }
    SEAM(0);
    if (IN(1)) { pg8::Gemm g{XN, WGU, T, 5632, DM}; pg8::StaticOrder S; S.init(T, 5632, G, bid); pg8::EpiSwiglu E{HB, SSQ};
        pg8::gemm_phase<pg8::EpiSwiglu, pg8::StaticOrder, true, true>(lds, g, S, E);
        if (G == 256 && bid >= 128) {
            __syncthreads();
            const int w0 = (bid - 128) * NWAVES + wave, nw = 128 * NWAVES;
            for (int it = 2816 + w0; it < FFN_ITEMS; it += nw) conv_ffn_item(it, f1g, f1u, f1d, WGU, WD, scr, lane);
            for (int it = w0; it < MIX_ITEMS; it += nw) conv_mix_item(it, w_in, w_a, w_b, w_o, WIN, WG, WA, WB, WO, scr, lane);
        }
    }
#if MK_PROBE & 4
    if (IN(1) && (args.probe & 4)) { pg8::Gemm g{XN, WGU, T, 5632, DM}; pg8::StaticOrder S; S.init(T, 5632, G, bid); pg8::EpiSwiglu E{HB, SSQ};
        pg8::gemm_phase<pg8::EpiSwiglu, pg8::StaticOrder, true, true>(lds, g, S, E); }
#endif
    SEAM(1);
    if (IN(2)) { pg8::Gemm g{HB, WD, T, DM, FF}; pg8::StaticOrder S; S.init(T, DM, G, bid); pg8::EpiResid E{x, out, XN, mix_norm, SSQ, 0.5f};
        pg8::gemm_phase<pg8::EpiResid, pg8::StaticOrder, true, true>(lds, g, S, E); }
    SEAM(2);
    if (IN(3)) { const int n3 = G > 64 ? 4096 : 5632;
        pg8::Gemm g{XN, WIN, T, n3, DM}; pg8::StaticOrder S; S.init(T, n3, G, bid); pg8::EpiIn E{ws, WS_QA, WS_VA, WS_QB, BD, SSQ, ROPEC, ROPES, a_log, dt_bias, 0};
        pg8::gemm_phase<pg8::EpiIn, pg8::StaticOrder, true, true>(lds, g, S, E); }
    SEAM(3);
    if (IN(4)) {
        const int nG = G > 64 ? 64 : G;
        #ifndef NO_GDN
#if MK_PROBE & 2
        if (bid < nG && (args.probe & 2)) for (int ch = bid; ch < 64; ch += nG) gdn_chain(lds, QB, BD, convw, gnorm, ch >> 3, ch & 7, tid, true);
#endif
        if (bid < nG) for (int ch = bid; ch < 64; ch += nG) gdn_chain(lds, QB, BD, convw, gnorm, ch >> 3, ch & 7, tid, false);
#endif
        const int a0 = G > 64 ? bid - 64 : bid, aN = G > 64 ? G - 64 : G;
        if (a0 >= 0) {
            unsigned round = 0; unsigned* sctr = (unsigned*)(ws + WS_CTL + 49152);
            if (G > 64) {
                pg8::Gemm g{XN, WIN + (size_t)16 * 256 * 1024, T, 1536, DM}; pg8::StaticOrder S; S.init(T, 1536, aN, a0); pg8::EpiIn E{ws, WS_QA, WS_VA, WS_QB, BD, SSQ, ROPEC, ROPES, a_log, dt_bias, 16};
                pg8::gemm_phase<pg8::EpiIn, pg8::StaticOrder, true, true>(lds, g, S, E);
                sub_barrier(sctr, (unsigned)aN, round);
            }
#ifndef NO_ATT
#if MK_PROBE & 8
            if (args.probe & 8) for (int u = a0; u < 1536; u += aN) attn_unit(lds, QA, KA, VA, LSE, u, tid, true);
#endif
            for (int u = a0; u < 1536; u += aN) attn_unit(lds, QA, KA, VA, LSE, u, tid, false);
#endif
            __syncthreads();
            for (int it = a0 * NWAVES + wave; it < FFN_ITEMS; it += aN * NWAVES) conv_ffn_item(it, f2g, f2u, f2d, WGU, WD, scr, lane);
            if (G > 64) {
                sub_barrier(sctr, (unsigned)aN, round);
                merge_groups(QA, LSE, YA, a0, aN, tid);
                sub_barrier(sctr, (unsigned)aN, round);
                { pg8::Gemm g{XN, WG + (size_t)1024 * 1024, T, 2048, DM}; pg8::StaticOrder S; S.init(T, 2048, aN, a0); pg8::EpiGates E{ws, WS_QB, WS_QA, SSQ, 4};
                  pg8::gemm_phase<pg8::EpiGates, pg8::StaticOrder, true, true>(lds, g, S, E); }
                sub_barrier(sctr, (unsigned)aN, round);
                { pg8::Gemm g{YA, WA, T, DM, 256}; pg8::StaticOrder S; S.init(T, DM, aN, a0); pg8::EpiBranch E{GA_, nullptr, GA_};
                  pg8::gemm_phase<pg8::EpiBranch, pg8::StaticOrder, true, true>(lds, g, S, E); }
            }
        }
    }
    SEAM(4);
    if (IN(5)) {
        if (G > 64) {
            pg8::Gemm g{XN, WG, T, 1024, DM}; pg8::StaticOrder S; S.init(T, 1024, G, bid); pg8::EpiGates E{ws, WS_QB, WS_QA, SSQ, 0};
            pg8::gemm_phase<pg8::EpiGates, pg8::StaticOrder, true, true>(lds, g, S, E);
        } else {
            merge_groups(QA, LSE, YA, bid, G, tid);
            xcd_barrier(bar);
            pg8::Gemm g{XN, WG, T, 3072, DM}; pg8::StaticOrder S; S.init(T, 3072, G, bid); pg8::EpiGates E{ws, WS_QB, WS_QA, SSQ, 0};
            pg8::gemm_phase<pg8::EpiGates, pg8::StaticOrder, true, true>(lds, g, S, E);
        }
    }
    SEAM(5);
    if (IN(6)) {
        if (G <= 64) {
        { pg8::Gemm g{YA, WA, T, DM, 256}; pg8::StaticOrder S; S.init(T, DM, G, bid); pg8::EpiBranch E{GA_, nullptr, GA_};
          pg8::gemm_phase<pg8::EpiBranch, pg8::StaticOrder, true, true>(lds, g, S, E); }
        __builtin_amdgcn_fence(__ATOMIC_RELEASE, "agent"); __syncthreads(); __builtin_amdgcn_fence(__ATOMIC_ACQUIRE, "agent");
        }
        { pg8::Gemm g{QB, WB, T, DM, DM}; pg8::StaticOrder S; S.init(T, DM, G, bid); pg8::EpiBranch E{GB_, GA_, GB_};
          pg8::gemm_phase<pg8::EpiBranch, pg8::StaticOrder, true, true>(lds, g, S, E); }
    }
    SEAM(6);
    if (IN(7)) { pg8::Gemm g{GB_, WO, T, DM, DM}; pg8::StaticOrder S; S.init(T, DM, G, bid); pg8::EpiResid E{out, out, XN, ffn2_norm, SSQ, 1.0f};
        pg8::gemm_phase<pg8::EpiResid, pg8::StaticOrder, true, true>(lds, g, S, E); }
    SEAM(7);
    if (IN(8)) { pg8::Gemm g{XN, WGU, T, 5632, DM}; pg8::StaticOrder S; S.init(T, 5632, G, bid); pg8::EpiSwiglu E{HB, SSQ};
        pg8::gemm_phase<pg8::EpiSwiglu, pg8::StaticOrder, true, true>(lds, g, S, E); }
    SEAM(8);
    if (IN(9)) { pg8::Gemm g{HB, WD, T, DM, FF}; pg8::StaticOrder S; S.init(T, DM, G, bid);
        if (G == 256) { pg8::EpiFinal E{out, out, final_norm, (float*)(ws + WS_XB), (unsigned*)(ws + WS_CTL + 32768), 0.5f};
            pg8::gemm_phase<pg8::EpiFinal, pg8::StaticOrder, true, true>(lds, g, S, E); }
        else {
            pg8::EpiResid E{out, out, nullptr, nullptr, SSQ, 0.5f}; pg8::gemm_phase<pg8::EpiResid, pg8::StaticOrder, true, true>(lds, g, S, E);
            xcd_barrier(bar);
            for (int m = gw; m < T; m += NGW) { const float rs = pg8::row_rs(SSQ, m); f32x4* xr = (f32x4*)(out + (size_t)m * DM) + lane;
#pragma unroll
                for (int j = 0; j < 4; ++j) { const f32x4 v = xr[64 * j]; const f32x4 g2 = *((const f32x4*)final_norm + lane + 64 * j); xr[64 * j] = (f32x4){v[0] * rs * g2[0], v[1] * rs * g2[1], v[2] * rs * g2[2], v[3] * rs * g2[3]}; } }
        }
    }
#undef IN
#undef SEAM
}

#ifndef MK_N_LAUNCHES
#define MK_N_LAUNCHES 1
#endif
extern "C" void kernel_launch(void* const* d_in, const int* in_sizes, int n_in, void* d_out, int out_size, void* d_ws, size_t ws_size, hipStream_t stream) {
    static int grid = 0;
    if (grid == 0) {
        if (n_in != 19 || out_size != T * DM || ws_size < WS_END) { fprintf(stderr, "kernel_launch: unexpected shapes (n_in %d out %d ws %zu)\n", n_in, out_size, ws_size); grid = -1; return; }
        int dev = 0, cus = 0, per_cu = 0;
        (void)hipGetDevice(&dev); (void)hipDeviceGetAttribute(&cus, hipDeviceAttributeMultiprocessorCount, dev);
        (void)hipFuncSetAttribute((const void*)mk_fwd, hipFuncAttributeMaxDynamicSharedMemorySize, LDS_BYTES);
        (void)hipOccupancyMaxActiveBlocksPerMultiprocessor(&per_cu, (const void*)mk_fwd, NTHR, LDS_BYTES);
        (void)hipGetLastError();
        if (per_cu < 1) fprintf(stderr, "kernel_launch: occupancy query says %d blocks per CU\n", per_cu);
        grid = cus > 0 ? cus : 256;
    }
    if (grid < 0) return;
    (void)hipMemsetAsync((char*)d_ws + WS_CTL, 0, CTL_ZERO_BYTES, stream);
    Args a{};
    for (int i = 0; i < 19; ++i) a.in[i] = (const float*)d_in[i];
    a.out = (float*)d_out; a.ws = (unsigned char*)d_ws;
#if MK_N_LAUNCHES == 1
    a.ph_lo = 0; a.ph_hi = 10; a.probe = MK_PROBE;
    void* kargs[] = {&a};
    hipError_t e = hipLaunchCooperativeKernel((const void*)mk_fwd, dim3(grid), dim3(NTHR), kargs, LDS_BYTES, stream);
    if (e != hipSuccess) fprintf(stderr, "cooperative launch failed: %s (grid %d)\n", hipGetErrorString(e), grid);
#else
    for (int p = 0; p < 11; ++p) { a.ph_lo = p; a.ph_hi = p + 1; hipLaunchKernelGGL(mk_fwd, dim3(grid), dim3(NTHR), LDS_BYTES, stream, a); }
#endif
}
```
